# Optimizing an MI355X kernel written in HIP

```python
import math
import jax, jax.numpy as jnp
from jax import lax
import numpy as np

D_MODEL = 2048
BATCH = 4
SEQ = 2048
DEPTH = 4

GRID_W = 64
CTX_LEN = 256
HEAD_DIM = 128
N_GROUPS = 4
GROUP_HEADS = D_MODEL // (N_GROUPS * HEAD_DIM)
GROUP_WIDTH = GROUP_HEADS * HEAD_DIM
MIX_WIDTH = N_GROUPS * GROUP_WIDTH
KV_HEADS = 2
KV_WIDTH = KV_HEADS * HEAD_DIM
DIFF_DIM = HEAD_DIM // 2
WINDOW = 128
Q_BLOCK = 128
NA_WIN_H = 8
NA_WIN_W = 16
NA_COL_BLOCK = 16
NA_KEY_COLS = NA_COL_BLOCK + NA_WIN_W
ROPE_THETA = 10000.0
EPS = 1e-6
NEG_INF = -1e30

IN_SIZES = (GROUP_WIDTH, GROUP_WIDTH, GROUP_WIDTH,
            GROUP_WIDTH, KV_WIDTH, KV_WIDTH,
            GROUP_WIDTH, GROUP_WIDTH, GROUP_WIDTH,
            GROUP_WIDTH, KV_WIDTH, KV_WIDTH,
            MIX_WIDTH)
IN_WIDTH = sum(IN_SIZES)

kernel_name = 'hybrid_parallel_group_dit_block'


def rms_norm(x, g):
    xf = x.astype(jnp.float32)
    y = xf * lax.rsqrt(jnp.mean(xf * xf, axis=-1, keepdims=True) + EPS)
    return (y * g.astype(jnp.float32)).astype(x.dtype)


def axial_rope_tables(n_tokens, dim, dtype):
    t = jnp.arange(n_tokens)
    row = (t // GRID_W).astype(jnp.float32)
    col = (t % GRID_W).astype(jnp.float32)
    n_freq = dim // 4
    inv = ROPE_THETA ** (-jnp.arange(n_freq, dtype=jnp.float32) / n_freq)
    ang = jnp.concatenate([row[:, None] * inv, col[:, None] * inv], axis=-1)
    return jnp.cos(ang).astype(dtype), jnp.sin(ang).astype(dtype)


def apply_rope(x, cos, sin):
    h = x.shape[-1] // 2
    x1, x2 = x[..., :h], x[..., h:]
    return jnp.concatenate([x1 * cos - x2 * sin, x2 * cos + x1 * sin], axis=-1)


def to_heads(t, n_heads, dim):
    b, s, _ = t.shape
    return t.reshape(b, s, n_heads, dim).transpose(0, 2, 1, 3)


def from_heads(t):
    b, h, s, d = t.shape
    return t.transpose(0, 2, 1, 3).reshape(b, s, h * d)


def diff_attention(q_lat, k_lat, v_lat, q_ctx, k_ctx, v_ctx, lam, subln_g, lambda_init, rope, with_ctx):
    cos, sin = rope
    b, s, _ = q_lat.shape
    H = GROUP_HEADS
    nblk = s // Q_BLOCK
    scale = DIFF_DIM ** -0.5

    def split2(t):
        n = t.shape[1]
        return t.reshape(b, n, H, 2, DIFF_DIM).transpose(0, 2, 3, 1, 4)

    ql = apply_rope(split2(q_lat), cos, sin)
    kl = apply_rope(split2(k_lat), cos, sin)
    kc = split2(k_ctx)
    vl, vc = to_heads(v_lat, H, HEAD_DIM), to_heads(v_ctx, H, HEAD_DIM)
    k_all = jnp.concatenate([kc, kl], axis=3)
    v_all = jnp.concatenate([vc, vl], axis=2)

    def attend(q, k, v):
        p = jax.nn.softmax(jnp.einsum('bhpqd,bhpkd->bhpqk', q, k).astype(jnp.float32) * scale, axis=-1)
        a = p[:, :, 0] - lam * p[:, :, 1]
        return jnp.einsum('bhqk,bhkd->bhqd', a.astype(v.dtype), v)

    qb = jnp.moveaxis(ql.reshape(b, H, 2, nblk, Q_BLOCK, DIFF_DIM), 3, 0)
    ob = lax.map(lambda qq: attend(qq, k_all, v_all), qb)
    o_lat = jnp.moveaxis(ob, 0, 2).reshape(b, H, s, HEAD_DIM)

    def post(o):
        return from_heads(rms_norm(o, subln_g) * (1.0 - lambda_init))

    if not with_ctx:
        return post(o_lat), None
    return post(o_lat), post(attend(split2(q_ctx), kc, vc))


def _band(t, nblk, side):
    b, hk, s, d = t.shape
    tp = jnp.pad(t, ((0, 0), (0, 0), (side * Q_BLOCK, side * Q_BLOCK), (0, 0)))
    tp = tp.reshape(b, hk, nblk + 2 * side, Q_BLOCK, d)
    return jnp.concatenate([tp[:, :, j:j + nblk] for j in range(2 * side + 1)], axis=3)


def window_attention(q_lat, k_lat, v_lat, q_ctx, k_ctx, v_ctx, sink, rope, with_ctx):
    cos, sin = rope
    b, s, _ = q_lat.shape
    L = k_ctx.shape[1]
    g = GROUP_HEADS // KV_HEADS
    nblk = s // Q_BLOCK
    side = WINDOW // Q_BLOCK
    nk = (2 * side + 1) * Q_BLOCK
    scale = HEAD_DIM ** -0.5
    ql = apply_rope(to_heads(q_lat, GROUP_HEADS, HEAD_DIM), cos, sin).reshape(b, KV_HEADS, g, nblk, Q_BLOCK, HEAD_DIM)
    kl = apply_rope(to_heads(k_lat, KV_HEADS, HEAD_DIM), cos, sin)
    vl = to_heads(v_lat, KV_HEADS, HEAD_DIM)
    kc, vc = to_heads(k_ctx, KV_HEADS, HEAD_DIM), to_heads(v_ctx, KV_HEADS, HEAD_DIM)
    kb, vb = _band(kl, nblk, side), _band(vl, nblk, side)
    n = np.arange(nblk)[:, None, None]
    t = np.arange(Q_BLOCK)[None, :, None]
    j = np.arange(nk)[None, None, :]
    qpos = n * Q_BLOCK + t
    kpos = (n - side) * Q_BLOCK + j
    valid = (np.abs(kpos - qpos) <= WINDOW) & (kpos >= 0) & (kpos < s)
    sink_hg = sink.astype(jnp.float32).reshape(KV_HEADS, g)
    s_band = jnp.where(valid, jnp.einsum('bkgnqd,bknjd->bkgnqj', ql, kb).astype(jnp.float32) * scale, NEG_INF)
    s_ctx = jnp.einsum('bkgnqd,bkld->bkgnql', ql, kc).astype(jnp.float32) * scale
    s_sink = jnp.broadcast_to(sink_hg[None, :, :, None, None, None], s_ctx.shape[:-1] + (1,))
    p = jax.nn.softmax(jnp.concatenate([s_band, s_ctx, s_sink], axis=-1), axis=-1).astype(vl.dtype)
    o = (jnp.einsum('bkgnqj,bknjd->bkgnqd', p[..., :nk], vb)
         + jnp.einsum('bkgnql,bkld->bkgnqd', p[..., nk:nk + L], vc))
    o_lat = from_heads(o.reshape(b, GROUP_HEADS, s, HEAD_DIM))
    if not with_ctx:
        return o_lat, None
    qc = to_heads(q_ctx, GROUP_HEADS, HEAD_DIM).reshape(b, KV_HEADS, g, L, HEAD_DIM)
    sc = jnp.einsum('bkgqd,bkld->bkgql', qc, kc).astype(jnp.float32) * scale
    sink_c = jnp.broadcast_to(sink_hg[None, :, :, None, None], sc.shape[:-1] + (1,))
    pc = jax.nn.softmax(jnp.concatenate([sc, sink_c], axis=-1), axis=-1)[..., :L].astype(vc.dtype)
    oc = jnp.einsum('bkgql,bkld->bkgqd', pc, vc).reshape(b, GROUP_HEADS, L, HEAD_DIM)
    return o_lat, from_heads(oc)


def neighborhood_attention(q_lat, k_lat, v_lat, q_ctx, k_ctx, v_ctx, rpb, with_ctx):
    b, s, _ = q_lat.shape
    rows = s // GRID_W
    H = GROUP_HEADS
    scale = HEAD_DIM ** -0.5
    wr = min(NA_WIN_H, rows)
    n_cb = GRID_W // NA_COL_BLOCK
    K = wr * NA_KEY_COLS
    r = np.arange(rows)
    key_rows = np.clip(r - wr // 2, 0, rows - wr)[:, None] + np.arange(wr)
    cb = np.arange(n_cb)
    key_cols = (np.clip(cb * NA_COL_BLOCK - NA_WIN_W // 2, 0, GRID_W - NA_KEY_COLS)[:, None]
                + np.arange(NA_KEY_COLS))
    qcol = cb[:, None] * NA_COL_BLOCK + np.arange(NA_COL_BLOCK)
    cstart = np.clip(qcol - NA_WIN_W // 2, 0, GRID_W - NA_WIN_W)
    key_idx = (key_rows[:, None, :, None] * GRID_W + key_cols[None, :, None, :]).reshape(rows, n_cb, K)
    col_ok = (key_cols[:, None, :] >= cstart[..., None]) & (key_cols[:, None, :] < cstart[..., None] + NA_WIN_W)
    valid = np.broadcast_to(col_ok[:, :, None, :], (n_cb, NA_COL_BLOCK, wr, NA_KEY_COLS)).reshape(n_cb, NA_COL_BLOCK, K)
    rel_r = key_rows - r[:, None] + NA_WIN_H - 1
    rel_c = np.clip(key_cols[:, None, :] - qcol[..., None] + NA_WIN_W - 1, 0, 2 * NA_WIN_W - 2)
    bias = rpb.astype(jnp.float32)[:, rel_r[:, None, None, :, None], rel_c[None, :, :, None, :]]
    bias = jnp.where(valid, bias.reshape(H, rows, n_cb, NA_COL_BLOCK, K), NEG_INF)

    ql = to_heads(q_lat, H, HEAD_DIM).reshape(b, H, rows, n_cb, NA_COL_BLOCK, HEAD_DIM)
    kl, vl = to_heads(k_lat, H, HEAD_DIM), to_heads(v_lat, H, HEAD_DIM)
    kc, vc = to_heads(k_ctx, H, HEAD_DIM), to_heads(v_ctx, H, HEAD_DIM)
    kg, vg = kl[:, :, key_idx], vl[:, :, key_idx]
    s_nb = jnp.einsum('bhrcqd,bhrckd->bhrcqk', ql, kg).astype(jnp.float32) * scale + bias
    s_ctx = jnp.einsum('bhrcqd,bhld->bhrcql', ql, kc).astype(jnp.float32) * scale
    p = jax.nn.softmax(jnp.concatenate([s_nb, s_ctx], axis=-1), axis=-1).astype(vl.dtype)
    o = (jnp.einsum('bhrcqk,bhrckd->bhrcqd', p[..., :K], vg)
         + jnp.einsum('bhrcql,bhld->bhrcqd', p[..., K:], vc))
    o_lat = from_heads(o.reshape(b, H, s, HEAD_DIM))
    if not with_ctx:
        return o_lat, None
    qc = to_heads(q_ctx, H, HEAD_DIM)
    pc = jax.nn.softmax(jnp.einsum('bhqd,bhld->bhql', qc, kc).astype(jnp.float32) * scale, axis=-1).astype(vc.dtype)
    return o_lat, from_heads(jnp.einsum('bhql,bhld->bhqd', pc, vc))


def qknorm_attention(q_lat, k_lat, v_lat, q_ctx, k_ctx, v_ctx, gq, gk, rope, with_ctx):
    cos, sin = rope
    b, s, _ = q_lat.shape
    L = k_ctx.shape[1]
    g = GROUP_HEADS // KV_HEADS
    nblk = s // Q_BLOCK
    scale = HEAD_DIM ** -0.5
    ql = apply_rope(rms_norm(to_heads(q_lat, GROUP_HEADS, HEAD_DIM), gq), cos, sin).reshape(b, KV_HEADS, g, s, HEAD_DIM)
    kl = apply_rope(rms_norm(to_heads(k_lat, KV_HEADS, HEAD_DIM), gk), cos, sin)
    vl = to_heads(v_lat, KV_HEADS, HEAD_DIM)
    kc = rms_norm(to_heads(k_ctx, KV_HEADS, HEAD_DIM), gk)
    vc = to_heads(v_ctx, KV_HEADS, HEAD_DIM)
    k_all = jnp.concatenate([kc, kl], axis=2)
    v_all = jnp.concatenate([vc, vl], axis=2)

    def attend(q, k, v):
        p = jax.nn.softmax(jnp.einsum('bkgqd,bksd->bkgqs', q, k).astype(jnp.float32) * scale, axis=-1)
        return jnp.einsum('bkgqs,bksd->bkgqd', p.astype(v.dtype), v)

    qb = jnp.moveaxis(ql.reshape(b, KV_HEADS, g, nblk, Q_BLOCK, HEAD_DIM), 3, 0)
    ob = lax.map(lambda qq: attend(qq, k_all, v_all), qb)
    o_lat = from_heads(jnp.moveaxis(ob, 0, 3).reshape(b, GROUP_HEADS, s, HEAD_DIM))
    if not with_ctx:
        return o_lat, None
    qc = rms_norm(to_heads(q_ctx, GROUP_HEADS, HEAD_DIM), gq).reshape(b, KV_HEADS, g, L, HEAD_DIM)
    return o_lat, from_heads(attend(qc, kc, vc).reshape(b, GROUP_HEADS, L, HEAD_DIM))


def setup_inputs(seed: int = 0) -> dict:
    key = jax.random.key(seed)
    ks = jax.random.split(key, 20)
    f32 = jnp.float32
    nrm = lambda k, shape: jax.random.normal(k, shape, f32)
    return {
        'x': nrm(ks[0], (BATCH, SEQ, D_MODEL)),
        'c': nrm(ks[1], (BATCH, D_MODEL)),
        'ctx': nrm(ks[2], (BATCH, CTX_LEN, D_MODEL)),
        'c_ctx': nrm(ks[3], (D_MODEL,)),
        'w_mod': nrm(ks[4], (DEPTH, D_MODEL, 3 * D_MODEL)) * (0.5 * D_MODEL ** -0.5),
        'b_mod': nrm(ks[5], (DEPTH, 3 * D_MODEL)) * 0.02,
        'pre_norm_g': 1.0 + 0.02 * nrm(ks[6], (DEPTH, D_MODEL)),
        'w_in': nrm(ks[7], (DEPTH, D_MODEL, IN_WIDTH)) * D_MODEL ** -0.5,
        'diff_lambda_q1': nrm(ks[8], (DEPTH, DIFF_DIM)) * 0.1,
        'diff_lambda_k1': nrm(ks[9], (DEPTH, DIFF_DIM)) * 0.1,
        'diff_lambda_q2': nrm(ks[10], (DEPTH, DIFF_DIM)) * 0.1,
        'diff_lambda_k2': nrm(ks[11], (DEPTH, DIFF_DIM)) * 0.1,
        'diff_subln_g': 1.0 + 0.02 * nrm(ks[12], (DEPTH, HEAD_DIM)),
        'win_sink': nrm(ks[13], (DEPTH, GROUP_HEADS)) * 0.5,
        'na_rpb': nrm(ks[14], (DEPTH, GROUP_HEADS, 2 * NA_WIN_H - 1, 2 * NA_WIN_W - 1)) * 0.1,
        'qk_q_norm_g': 1.0 + 0.02 * nrm(ks[15], (DEPTH, HEAD_DIM)),
        'qk_k_norm_g': 1.0 + 0.02 * nrm(ks[16], (DEPTH, HEAD_DIM)),
        'w_out': nrm(ks[17], (DEPTH, MIX_WIDTH, D_MODEL)) * MIX_WIDTH ** -0.5,
        'post_norm_g': 1.0 + 0.02 * nrm(ks[18], (DEPTH, D_MODEL)),
    }


def reference(x, c, ctx, c_ctx, w_mod, b_mod, pre_norm_g, w_in, diff_lambda_q1, diff_lambda_k1,
              diff_lambda_q2, diff_lambda_k2, diff_subln_g, win_sink, na_rpb, qk_q_norm_g, qk_k_norm_g,
              w_out, post_norm_g):
    b, s, _ = x.shape
    rope_sub = axial_rope_tables(s, DIFF_DIM, x.dtype)
    rope_head = axial_rope_tables(s, HEAD_DIM, x.dtype)
    split_points = [int(v) for v in np.cumsum(IN_SIZES)[:-1]]
    silu_c = jax.nn.silu(c)
    silu_cc = jax.nn.silu(c_ctx)
    h, hc = x, ctx
    for l in range(DEPTH):
        with_ctx = l < DEPTH - 1
        shift, scale, gate = jnp.split(silu_c @ w_mod[l] + b_mod[l], 3, axis=-1)
        shift_c, scale_c, gate_c = jnp.split(silu_cc @ w_mod[l] + b_mod[l], 3, axis=-1)
        n = rms_norm(h, pre_norm_g[l]) * (1.0 + scale[:, None]) + shift[:, None]
        nc = rms_norm(hc, pre_norm_g[l]) * (1.0 + scale_c) + shift_c
        p = jnp.split(n @ w_in[l], split_points, axis=-1)
        pc = jnp.split(nc @ w_in[l], split_points, axis=-1)

        lambda_init = 0.8 - 0.6 * math.exp(-0.3 * l)
        lam = (jnp.exp(jnp.sum(diff_lambda_q1[l].astype(jnp.float32) * diff_lambda_k1[l].astype(jnp.float32)))
               - jnp.exp(jnp.sum(diff_lambda_q2[l].astype(jnp.float32) * diff_lambda_k2[l].astype(jnp.float32)))
               + lambda_init)
        oa, oa_c = diff_attention(p[0], p[1], p[2], pc[0], pc[1], pc[2], lam, diff_subln_g[l], lambda_init,
                                  rope_sub, with_ctx)
        ob, ob_c = window_attention(p[3], p[4], p[5], pc[3], pc[4], pc[5], win_sink[l], rope_head, with_ctx)
        on, on_c = neighborhood_attention(p[6], p[7], p[8], pc[6], pc[7], pc[8], na_rpb[l], with_ctx)
        od, od_c = qknorm_attention(p[9], p[10], p[11], pc[9], pc[10], pc[11], qk_q_norm_g[l], qk_k_norm_g[l],
                                    rope_head, with_ctx)

        y = (jnp.concatenate([oa, ob, on, od], axis=-1) * jax.nn.silu(p[12])) @ w_out[l]
        h = h + gate[:, None] * rms_norm(y, post_norm_g[l])
        if with_ctx:
            yc = (jnp.concatenate([oa_c, ob_c, on_c, od_c], axis=-1) * jax.nn.silu(pc[12])) @ w_out[l]
            hc = hc + gate_c * rms_norm(yc, post_norm_g[l])
    return h
```

```cpp
#include <hip/hip_runtime.h>
#include <hip/hip_cooperative_groups.h>
#include <cstdio>
namespace cg = cooperative_groups;

#define DI __device__ __forceinline__
typedef short bf16x8 __attribute__((ext_vector_type(8)));
typedef short s16x4 __attribute__((ext_vector_type(4)));
typedef float f32x16 __attribute__((ext_vector_type(16)));
typedef float f32x4 __attribute__((ext_vector_type(4)));
typedef unsigned u32x4 __attribute__((ext_vector_type(4)));
typedef unsigned u32x2 __attribute__((ext_vector_type(2)));
typedef __bf16 bf2_t __attribute__((ext_vector_type(2)));
typedef float f2_t __attribute__((ext_vector_type(2)));
typedef unsigned short u16;

constexpr int DM = 2048;
constexpr int TPB = 2304;
constexpr int NTOK = 9216;
constexpr int INW = 7168;
constexpr int SMEM_BYTES = 147456;
constexpr int NTHR = 512;
constexpr int GEMM_PROBE = 0;
constexpr int ATT_PROBE = 0;
constexpr bool ATT_SKEW = false;
constexpr int DUP_SUB = -1;
constexpr float LOG2E = 1.4426950408889634f;
constexpr float EPSV = 1e-6f;

struct Params {
  const float *x, *c, *ctx, *c_ctx, *w_mod, *b_mod, *pre_g, *w_in, *lq1, *lk1, *lq2, *lk2, *subln_g, *sink, *rpb, *gq, *gk, *w_out, *post_g;
  float* out;
  u16 *wt_in, *wt_out, *nbuf, *P, *O;
  float *hc, *modpart, *mod, *rope128, *rope64, *asave;
  u16 *y, *ypart;
  int* counters;
  unsigned* bar;
  int phase_lo, phase_hi;
};

DI unsigned pack2(float a, float b) { f2_t v = {a, b}; bf2_t r = __builtin_convertvector(v, bf2_t); return __builtin_bit_cast(unsigned, r); }
DI float bf_lo(unsigned u) { return __uint_as_float(u << 16); }
DI float bf_hi(unsigned u) { return __uint_as_float(u & 0xffff0000u); }
DI float fexp2(float x) { return __builtin_amdgcn_exp2f(x); }
DI f32x16 mfma32(bf16x8 a, bf16x8 b, f32x16 c) { return __builtin_amdgcn_mfma_f32_32x32x16_bf16(a, b, c, 0, 0, 0); }
template <int K> DI float swz_xor(float v) { return __uint_as_float(__builtin_amdgcn_ds_swizzle(__float_as_uint(v), (K << 10) | 0x1f)); }
DI float half_sum(float v) { const auto r = __builtin_amdgcn_permlane32_swap(__float_as_uint(v), __float_as_uint(v), false, false); return __uint_as_float(r[0]) + __uint_as_float(r[1]); }
DI float half_max(float v) { const auto r = __builtin_amdgcn_permlane32_swap(__float_as_uint(v), __float_as_uint(v), false, false); return fmaxf(__uint_as_float(r[0]), __uint_as_float(r[1])); }
DI float wave_sum(float v) {
  v = half_sum(v);
  v += swz_xor<16>(v); v += swz_xor<8>(v); v += swz_xor<4>(v); v += swz_xor<2>(v); v += swz_xor<1>(v);
  return v;
}
DI s16x4 tr_read(const char* p) {
  return __builtin_amdgcn_ds_read_tr16_b64_v4i16((s16x4 __attribute__((address_space(3)))*)(p));
}

DI void phase0(const Params& p, char* smem, int wv) {
  int lane_; asm volatile("v_mbcnt_lo_u32_b32 %0, -1, 0\n\tv_mbcnt_hi_u32_b32 %0, -1, %0" : "=v"(lane_)); asm volatile("" : "+s"(wv));
  const int tid_ = wv * 64 + lane_;
  const int tid = tid_, lane = lane_, w = wv;
  if (blockIdx.x == 0 && tid < 8) p.counters[tid] = 0;
  constexpr int N_MOD = 192, N_TRIN = 3584, N_TROUT = 1024, N_ROPE = 0;
  float* sf = (float*)smem;
  for (int it = blockIdx.x; it < N_MOD; it += gridDim.x) {
    const int l = it / 48, rem = it % 48, kc = rem / 3, cg4 = rem % 3;
    for (int idx = tid; idx < 640; idx += NTHR) {
      const int r = idx >> 7, k = idx & 127;
      const float v = (r < 4) ? p.c[r * DM + kc * 128 + k] : p.c_ctx[kc * 128 + k];
      sf[idx] = v / (1.f + __expf(-v));
    }
    __syncthreads();
    const int col = (cg4 * 8 + w) * 256 + lane * 4;
    const float* wp = p.w_mod + ((size_t)l * DM + kc * 128) * 6144 + col;
    f32x4 a0 = {0, 0, 0, 0}, a1 = a0, a2 = a0, a3 = a0, a4 = a0;
#pragma unroll 16
    for (int k = 0; k < 128; ++k) {
      const f32x4 wvv = *(const f32x4*)(wp + (size_t)k * 6144);
      a0 += sf[k] * wvv; a1 += sf[128 + k] * wvv; a2 += sf[256 + k] * wvv; a3 += sf[384 + k] * wvv; a4 += sf[512 + k] * wvv;
    }
    float* mp = p.modpart + (size_t)(kc * 4 + l) * 30720 + col;
    *(f32x4*)(mp) = a0; *(f32x4*)(mp + 6144) = a1; *(f32x4*)(mp + 2 * 6144) = a2;
    *(f32x4*)(mp + 3 * 6144) = a3; *(f32x4*)(mp + 4 * 6144) = a4;
    __syncthreads();
  }
  {
    constexpr int N_TR = N_TRIN + N_TROUT;
    auto tr_desc = [&](int ti, const float*& src, u16*& dst, int& N, int& kt, int& nt) {
      if (ti < N_TRIN) {
        const int l = ti / 896, rem = ti % 896; kt = rem / 56; nt = rem % 56; N = INW;
        src = p.w_in + (size_t)l * DM * INW; dst = p.wt_in + (size_t)l * INW * DM;
      } else {
        const int t2 = ti - N_TRIN;
        const int l = t2 / 256, rem = t2 % 256; kt = rem / 16; nt = rem % 16; N = DM;
        src = p.w_out + (size_t)l * DM * DM; dst = p.wt_out + (size_t)l * DM * DM;
      }
    };
    const int row0 = tid >> 5, c4 = (tid & 31) * 4;
    const int g = gridDim.x;
    int ti = (blockIdx.x + g - (N_MOD % g)) % g;
    f32x4 v[8];
    const float* src; u16* dst; int N, kt, nt;
    if (ti < N_TR) {
      tr_desc(ti, src, dst, N, kt, nt);
#pragma unroll
      for (int i = 0; i < 8; ++i) v[i] = *(const f32x4*)(src + (size_t)(kt * 128 + row0 + 16 * i) * N + nt * 128 + c4);
    }
    for (; ti < N_TR; ti += g) {
#pragma unroll
      for (int i = 0; i < 8; ++i) {
        float* d = sf + (row0 + 16 * i) * 129 + c4;
        d[0] = v[i][0]; d[1] = v[i][1]; d[2] = v[i][2]; d[3] = v[i][3];
      }
      __syncthreads();
      u16* dcur = dst; const int ktc = kt, ntc = nt;
      if (ti + g < N_TR) {
        tr_desc(ti + g, src, dst, N, kt, nt);
#pragma unroll
        for (int i = 0; i < 8; ++i) v[i] = *(const f32x4*)(src + (size_t)(kt * 128 + row0 + 16 * i) * N + nt * 128 + c4);
      }
#pragma unroll
      for (int i = 0; i < 4; ++i) {
        const int n = (tid >> 4) + 32 * i, k8 = (tid & 15) * 8;
        u32x4 o;
        o[0] = pack2(sf[(k8 + 0) * 129 + n], sf[(k8 + 1) * 129 + n]);
        o[1] = pack2(sf[(k8 + 2) * 129 + n], sf[(k8 + 3) * 129 + n]);
        o[2] = pack2(sf[(k8 + 4) * 129 + n], sf[(k8 + 5) * 129 + n]);
        o[3] = pack2(sf[(k8 + 6) * 129 + n], sf[(k8 + 7) * 129 + n]);
        *(u32x4*)(dcur + (size_t)(ntc * 128 + n) * DM + ktc * 128 + k8) = o;
      }
      __syncthreads();
    }
  }
}

DI void phase1(const Params& p, int wv) {
  int lane_; asm volatile("v_mbcnt_lo_u32_b32 %0, -1, 0\n\tv_mbcnt_hi_u32_b32 %0, -1, %0" : "=v"(lane_)); asm volatile("" : "+s"(wv));
  const int tid_ = wv * 64 + lane_;
  for (int idx = blockIdx.x * NTHR + tid_; idx < 4 * 30720; idx += gridDim.x * NTHR) {
    const int l = idx / 30720, rem = idx % 30720, col = rem % 6144;
    float s = p.b_mod[l * 6144 + col];
#pragma unroll
    for (int kc = 0; kc < 16; ++kc) s += p.modpart[(size_t)(kc * 4 + l) * 30720 + rem];
    p.mod[idx] = s;
  }
}

DI void rowpass(const Params& p, int l, bool first, int wv, char* smem) {
  int lane_; asm volatile("v_mbcnt_lo_u32_b32 %0, -1, 0\n\tv_mbcnt_hi_u32_b32 %0, -1, %0" : "=v"(lane_)); asm volatile("" : "+s"(wv));
  const int tid_ = wv * 64 + lane_;
  const int lane = lane_, w = wv;
  const int lnext = first ? 0 : l + 1;
  float* lg_post = (float*)smem;
  float* lg_pre = (float*)smem + 2048;
  {
    const int t4 = (wv * 64 + lane_) * 4;
    if (!first) *(f32x4*)(lg_post + t4) = *(const f32x4*)(p.post_g + l * DM + t4);
    if (first || l < 3) *(f32x4*)(lg_pre + t4) = *(const f32x4*)(p.pre_g + lnext * DM + t4);
    __syncthreads();
  }
  for (int R = blockIdx.x * 8 + w; R < NTOK; R += gridDim.x * 8) {
    const int b = R / TPB, j = R - b * TPB;
    const bool isctx = j < 256;
    const int mr = isctx ? 4 : b;
    if (!first && l == 3 && isctx) continue;
    const float* hin; float* hout;
    if (isctx) {
      hout = p.hc + (size_t)(b * 256 + j) * DM;
      hin = (first || l == 0) ? p.ctx + (size_t)(b * 256 + j) * DM : hout;
    } else {
      hout = p.out + (size_t)(b * 2048 + (j - 256)) * DM;
      hin = (first || l == 0) ? p.x + (size_t)(b * 2048 + (j - 256)) * DM : hout;
    }
    f32x4 hv[8];
#pragma unroll
    for (int i = 0; i < 8; ++i) hv[i] = *(const f32x4*)(hin + i * 256 + lane * 4);
    if (!first) {
      f32x4 yv[8];
      float ss = 0.f;
      if (!isctx) {
        const u16* yp = p.y + (size_t)R * DM;
#pragma unroll
        for (int i = 0; i < 8; ++i) {
          const u32x2 u = *(const u32x2*)(yp + i * 256 + lane * 4);
          yv[i][0] = bf_lo(u[0]); yv[i][1] = bf_hi(u[0]); yv[i][2] = bf_lo(u[1]); yv[i][3] = bf_hi(u[1]);
        }
      } else {
#pragma unroll
        for (int i = 0; i < 8; ++i) yv[i] = (f32x4){0.f, 0.f, 0.f, 0.f};
#pragma unroll 4
        for (int kc = 0; kc < 8; ++kc) {
          const u16* yp = p.ypart + ((size_t)kc * 1024 + (size_t)(b * 256 + j)) * DM;
#pragma unroll
          for (int i = 0; i < 8; ++i) {
            const u32x2 u = *(const u32x2*)(yp + i * 256 + lane * 4);
            yv[i][0] += bf_lo(u[0]); yv[i][1] += bf_hi(u[0]); yv[i][2] += bf_lo(u[1]); yv[i][3] += bf_hi(u[1]);
          }
        }
      }
#pragma unroll
      for (int i = 0; i < 8; ++i) ss += yv[i][0] * yv[i][0] + yv[i][1] * yv[i][1] + yv[i][2] * yv[i][2] + yv[i][3] * yv[i][3];
      const float* gate = p.mod + (size_t)(l * 5 + mr) * 6144 + 4096;
      f32x4 gtv[8];
#pragma unroll
      for (int i = 0; i < 8; ++i) gtv[i] = *(const f32x4*)(gate + i * 256 + lane * 4);
      f32x4 shv[8], scv[8];
      if (l < 3) {
        const float* shift = p.mod + (size_t)(lnext * 5 + mr) * 6144;
#pragma unroll
        for (int i = 0; i < 8; ++i) { shv[i] = *(const f32x4*)(shift + i * 256 + lane * 4); scv[i] = *(const f32x4*)(shift + 2048 + i * 256 + lane * 4); }
      }
      ss = wave_sum(ss);
      const float r1 = rsqrtf(ss * (1.f / DM) + EPSV);
#pragma unroll
      for (int i = 0; i < 8; ++i) {
        const f32x4 gpv = *(const f32x4*)(lg_post + i * 256 + lane * 4);
#pragma unroll
        for (int e = 0; e < 4; ++e) hv[i][e] += gtv[i][e] * ((yv[i][e] * r1) * gpv[e]);
        *(f32x4*)(hout + i * 256 + lane * 4) = hv[i];
      }
      if (l < 3) {
        float s2 = 0.f;
#pragma unroll
        for (int i = 0; i < 8; ++i) s2 += hv[i][0] * hv[i][0] + hv[i][1] * hv[i][1] + hv[i][2] * hv[i][2] + hv[i][3] * hv[i][3];
        s2 = wave_sum(s2);
        const float r2 = rsqrtf(s2 * (1.f / DM) + EPSV);
        u16* np = p.nbuf + (size_t)R * DM;
#pragma unroll
        for (int i = 0; i < 8; ++i) {
          const f32x4 grv = *(const f32x4*)(lg_pre + i * 256 + lane * 4);
          float o[4];
#pragma unroll
          for (int e = 0; e < 4; ++e) o[e] = ((hv[i][e] * r2) * grv[e]) * (1.f + scv[i][e]) + shv[i][e];
          u32x2 pk; pk[0] = pack2(o[0], o[1]); pk[1] = pack2(o[2], o[3]);
          *(u32x2*)(np + i * 256 + lane * 4) = pk;
        }
      }
      continue;
    }
    {
      float ss = 0.f;
#pragma unroll
      for (int i = 0; i < 8; ++i) ss += hv[i][0] * hv[i][0] + hv[i][1] * hv[i][1] + hv[i][2] * hv[i][2] + hv[i][3] * hv[i][3];
      ss = wave_sum(ss);
      const float r2 = rsqrtf(ss * (1.f / DM) + EPSV);
      const float* shift = p.mod + (size_t)(lnext * 5 + mr) * 6144;
      const float* scale = shift + 2048;
      const float* gpre = p.pre_g + lnext * DM;
      u16* np = p.nbuf + (size_t)R * DM;
#pragma unroll
      for (int i = 0; i < 8; ++i) {
        const f32x4 sh = *(const f32x4*)(shift + i * 256 + lane * 4);
        const f32x4 sc = *(const f32x4*)(scale + i * 256 + lane * 4);
        const f32x4 gp = *(const f32x4*)(gpre + i * 256 + lane * 4);
        float o[4];
#pragma unroll
        for (int e = 0; e < 4; ++e) o[e] = ((hv[i][e] * r2) * gp[e]) * (1.f + sc[e]) + sh[e];
        u32x2 pk; pk[0] = pack2(o[0], o[1]); pk[1] = pack2(o[2], o[3]);
        *(u32x2*)(np + i * 256 + lane * 4) = pk;
      }
    }
  }
}

#define LAS __attribute__((address_space(3)))
constexpr int G_HTB = 128 * 64 * 2;
DI int lds_byte(int r, int c) { const int stt = (r >> 4) * 2 + (c >> 5), rr = r & 15, cc = c & 31, ob = rr * 64 + cc * 2; return stt * 1024 + (ob ^ (((ob >> 9) & 1) << 5)); }
DI void stage_rc(int b, int& R, int& C) { const int stt = b / 1024, sb = b % 1024, swz = sb ^ (((sb >> 9) & 1) << 5); R = (stt >> 1) * 16 + swz / 64; C = (stt & 1) * 32 + (swz % 64) / 2; }

template <int GP> DI void gemm_phase(const Params& p, int l, int which, char* smem, int wv) {
  int lane_; asm volatile("v_mbcnt_lo_u32_b32 %0, -1, 0\n\tv_mbcnt_hi_u32_b32 %0, -1, %0" : "=v"(lane_)); asm volatile("" : "+s"(wv));
  const int lane = lane_, wid = wv, tid = wid * 64 + lane, wr = wid >> 2, wc = wid & 3, fr = lane & 15, fq = lane >> 4;
  LAS unsigned char* lds = (LAS unsigned char*)smem;
  float* xs = (float*)(smem + 8 * G_HTB);
  const u16* Aglob = which ? p.O : p.nbuf;
  const u16* Wt = which ? p.wt_out + (size_t)l * DM * DM : p.wt_in + (size_t)l * INW * DM;
  const int NT = which ? 8 : 28;
  const int NH = NT >> 1;
  const int chunk = which ? 64 : 9 * NH;
  const int xcd = blockIdx.x & 7, nbx = gridDim.x >> 3;
  constexpr int K = DM;
  auto unit_ok = [&](int t, int& mt, int& nt, int& k0, int& nk) -> bool {
    if (which) {
      const int bb = xcd >> 1, nh = xcd & 1;
      if (t < 32) { mt = bb * 9 + 1 + (t & 7); nt = nh * 4 + (t >> 3); k0 = 0; nk = 32; return true; }
      if (l == 3) return false;
      const int c = t - 32; mt = bb * 9; nt = nh * 4 + (c >> 3); k0 = (c & 7) * 256; nk = 4; return true;
    }
    mt = (xcd >> 1) * 9 + (t % 9); nt = (xcd & 1) * NH + t / 9; k0 = 0; nk = 32;
    if (l == 3 && (mt % 9) == 0)
      return (nt >= 2 && nt < 6) || (nt >= 8 && nt < 10) || (nt >= 12 && nt < 16) || (nt >= 18 && nt < 20);
    return true;
  };
  auto next_unit = [&](int t, int& mt, int& nt, int& k0, int& nk) -> int {
    for (t += nbx; t < chunk; t += nbx) if (unit_ok(t, mt, nt, k0, nk)) return t;
    return -1;
  };
  unsigned voffA[2];
#pragma unroll
  for (int i = 0; i < 2; ++i) { int R, C; stage_rc(tid * 16 + i * 8192, R, C); voffA[i] = (unsigned)(R * K + C) * 2u; }
  auto voffB = [&](int i, int hf, bool m32) -> unsigned {
    int t2 = tid; asm volatile("" : "+v"(t2));
    int R, C; stage_rc(t2 * 16 + i * 8192, R, C);
    const int swc = R >> 5, sn = (R >> 4) & 1, sfq = (R >> 2) & 3, sj = R & 3;
    const int c = m32 ? ((swc >> 1) * 128 + (swc & 1) * 64 + hf * 32 + sfq * 8 + sn * 4 + sj)
                      : ((swc >> 1) * 128 + hf * 64 + (swc & 1) * 32 + sfq * 8 + sn * 4 + sj);
    return (unsigned)(c * K + C) * 2u;
  };
  const size_t kstep = 128;
  const size_t hstep = (size_t)128 * K * 2;
  const size_t tstep = 2 * hstep;
  const unsigned ldsw = (unsigned)wid * 1024u;
  const int aoff = lds_byte(wr * 64 + fr, fq * 8), boff = lds_byte(wc * 32 + fr, fq * 8);
#define G_SA(b, h) (((b) * 2 + (h)) * G_HTB)
#define G_SB(b, h) ((4 + (b) * 2 + (h)) * G_HTB)
#define G_STAGE(bufoff, gbase, voff) do { _Pragma("unroll") for (int _i = 0; _i < 2; ++_i) \
    __builtin_amdgcn_global_load_lds((const unsigned*)((const char*)(gbase) + (voff)[_i]), (LAS unsigned*)(lds + (bufoff) + ldsw + _i * 8192), 16, 0, 0); } while (0)
#define G_LDA(dst, b, h) do { _Pragma("unroll") for (int m = 0; m < 4; ++m) _Pragma("unroll") for (int k = 0; k < 2; ++k) dst[m][k] = *(const LAS bf16x8*)(lds + G_SA(b, h) + aoff + m * 2048 + k * 1024); } while (0)
#define G_LDB(dst, b, h) do { _Pragma("unroll") for (int n = 0; n < 2; ++n) _Pragma("unroll") for (int k = 0; k < 2; ++k) dst[n][k] = *(const LAS bf16x8*)(lds + G_SB(b, h) + boff + n * 2048 + k * 1024); } while (0)
#define G_MMA(ai, bj, At, Bt) do { __builtin_amdgcn_s_setprio(1); _Pragma("unroll") for (int m = 0; m < 4; ++m) _Pragma("unroll") for (int n = 0; n < 2; ++n) _Pragma("unroll") for (int k = 0; k < 2; ++k) \
    acc[ai][bj][m][n] = __builtin_amdgcn_mfma_f32_16x16x32_bf16(Bt[n][k], At[m][k], acc[ai][bj][m][n], 0, 0, 0); __builtin_amdgcn_s_setprio(0); } while (0)
#define G_WAIT_V(n) asm volatile("s_waitcnt vmcnt(" #n ")" ::: "memory")
#define G_WAIT_L(n) asm volatile("s_waitcnt lgkmcnt(" #n ")" ::: "memory")
#define G_BAR __builtin_amdgcn_s_barrier()
#define G_SCHED __builtin_amdgcn_sched_barrier(0)
  int cmt, cnt_, ck0, cnk, nmt = 0, nnt = 0, nk0 = 0, nnk = 32;
  int ct = next_unit((blockIdx.x >> 3) - nbx, cmt, cnt_, ck0, cnk);
  if (ct < 0) return;
  f32x4 acc[2][2][4][2];
#pragma unroll
  for (int a = 0; a < 2; ++a)
#pragma unroll
    for (int b = 0; b < 2; ++b)
#pragma unroll
      for (int m = 0; m < 4; ++m)
#pragma unroll
        for (int n = 0; n < 2; ++n) acc[a][b][m][n] = (f32x4){0.f, 0.f, 0.f, 0.f};
  bf16x8 At[4][2], B0[2][2], B1[2][2];
  const char* cA = (const char*)Aglob + (size_t)cmt * tstep + (size_t)ck0 * 2;
  const char* cB = (const char*)Wt + (size_t)cnt_ * tstep + (size_t)ck0 * 2;
  bool c32 = (!which) && (cnt_ < 4);
  unsigned vb0[2], vb1[2];
#pragma unroll
  for (int i = 0; i < 2; ++i) { vb0[i] = voffB(i, 0, c32); vb1[i] = voffB(i, 1, c32); }
  G_STAGE(G_SB(0, 0), cB, vb0); G_STAGE(G_SA(0, 0), cA, voffA); G_STAGE(G_SB(0, 1), cB, vb1); G_STAGE(G_SA(0, 1), cA + hstep, voffA);
  if (wr == 1) G_BAR;
  G_WAIT_V(4); G_BAR;
  G_STAGE(G_SB(1, 0), cB + kstep, vb0); G_STAGE(G_SA(1, 0), cA + kstep, voffA); G_STAGE(G_SB(1, 1), cB + kstep, vb1);
  G_WAIT_V(6); G_BAR;
  for (;;) {
    const int ntn = next_unit(ct, nmt, nnt, nk0, nnk);
    const bool has_next = ntn >= 0;
    const char* nA = has_next ? (const char*)Aglob + (size_t)nmt * tstep + (size_t)nk0 * 2 : cA;
    const char* nB = has_next ? (const char*)Wt + (size_t)nnt * tstep + (size_t)nk0 * 2 : cB;
    const bool n32 = has_next ? ((!which) && (nnt < 4)) : c32;
    for (int t = 0; t < cnk; t += 2) {
      const bool last = (t == cnk - 2);
      const char* a1 = cA + (size_t)(t + 1) * kstep;
      const char* a2 = last ? nA : cA + (size_t)(t + 2) * kstep; const char* b2 = last ? nB : cB + (size_t)(t + 2) * kstep;
      const char* a3 = a2 + kstep; const char* b3 = b2 + kstep;
      if (last) {
#pragma unroll
        for (int i = 0; i < 2; ++i) { vb0[i] = voffB(i, 0, n32); vb1[i] = voffB(i, 1, n32); }
      }
      G_LDB(B0, 0, 0); G_SCHED; G_LDA(At, 0, 0); G_STAGE(G_SA(1, 1), a1 + hstep, voffA);
      G_WAIT_L(8); G_BAR; G_WAIT_L(0); G_MMA(0, 0, At, B0); G_BAR; G_SCHED;
      G_LDB(B1, 0, 1); G_STAGE(G_SB(0, 0), b2, vb0);
      G_BAR; G_WAIT_L(0); G_MMA(0, 1, At, B1); G_BAR;
      G_LDA(At, 0, 1); G_STAGE(G_SA(0, 0), a2, voffA);
      G_BAR; G_WAIT_L(0); G_MMA(1, 0, At, B0); G_BAR; G_SCHED;
      G_STAGE(G_SB(0, 1), b2, vb1);
      G_WAIT_V(6); G_BAR; G_MMA(1, 1, At, B1); G_BAR;
      G_LDB(B0, 1, 0); G_SCHED; G_LDA(At, 1, 0); G_STAGE(G_SA(0, 1), a2 + hstep, voffA);
      G_WAIT_L(8); G_BAR; G_WAIT_L(0); G_MMA(0, 0, At, B0); G_BAR; G_SCHED;
      G_LDB(B1, 1, 1); G_STAGE(G_SB(1, 0), b3, vb0);
      G_BAR; G_WAIT_L(0); G_MMA(0, 1, At, B1); G_BAR;
      G_LDA(At, 1, 1); G_STAGE(G_SA(1, 0), a3, voffA);
      G_BAR; G_WAIT_L(0); G_MMA(1, 0, At, B0); G_BAR; G_SCHED;
      G_STAGE(G_SB(1, 1), b3, vb1);
      G_WAIT_V(6); G_BAR; G_MMA(1, 1, At, B1); G_BAR;
    }
    if (GP == 0) {
      const int m0 = cmt * 256, n0 = cnt_ * 256;
      const bool isctx = (cmt % 9) == 0;
      const int head = wc >> 1;
      const int n128 = cnt_ * 2 + head;
      const int rowl0 = wr * 64 + fr;
      if (which) {
        const int colb = n0 + head * 128 + (wc & 1) * 32 + fq * 8;
        u16* ybase = isctx ? p.ypart + ((size_t)(ck0 >> 8) * 1024 + (size_t)(cmt / 9) * 256) * DM : p.y + (size_t)m0 * DM;
#pragma unroll
        for (int ai = 0; ai < 2; ++ai)
#pragma unroll
          for (int m = 0; m < 4; ++m) {
            u16* yp = ybase + (size_t)(rowl0 + ai * 128 + m * 16) * DM + colb;
#pragma unroll
            for (int bj = 0; bj < 2; ++bj) {
              u32x4 o;
              o[0] = pack2(acc[ai][bj][m][0][0], acc[ai][bj][m][0][1]); o[1] = pack2(acc[ai][bj][m][0][2], acc[ai][bj][m][0][3]);
              o[2] = pack2(acc[ai][bj][m][1][0], acc[ai][bj][m][1][1]); o[3] = pack2(acc[ai][bj][m][1][2], acc[ai][bj][m][1][3]);
              *(u32x4*)(yp + bj * 64) = o;
            }
          }
        __builtin_amdgcn_s_waitcnt(0x0F70);
      } else {
        int hh = 64; bool rope = false, silu = false; float qmul = 1.f; const float* ng = nullptr;
        if (n128 < 4) { hh = 32; rope = true; qmul = 0.125f * LOG2E; }
        else if (n128 < 8) { hh = 32; rope = true; }
        else if (n128 < 12) { }
        else if (n128 < 16) { rope = true; qmul = 0.08838834764831845f * LOG2E; }
        else if (n128 < 18) { rope = true; }
        else if (n128 < 20) { }
        else if (n128 < 24) { qmul = 0.08838834764831845f * LOG2E; }
        else if (n128 < 32) { }
        else if (n128 < 36) { rope = true; qmul = 0.08838834764831845f * LOG2E; ng = p.gq + l * 128; }
        else if (n128 < 38) { rope = true; ng = p.gk + l * 128; }
        else if (n128 < 40) { }
        else { silu = true; }
        const bool normtile = (cnt_ >= 16 && cnt_ < 19);
        const int c1 = (hh == 64) ? ((wc & 1) * 32 + fq * 8) : ((wc & 1) * 64 + fq * 8);
        const int c2 = c1 + hh;
        const int nfq = (hh == 64) ? 32 : 16;
        const int j0 = c1 & 63;
        const bool use_col = (j0 >= nfq);
        float frev[8];
#pragma unroll
        for (int e = 0; e < 8; ++e) frev[e] = rope ? fexp2(-(float)((j0 + e) & (nfq - 1)) * (13.287712379549449f / (float)nfq)) * 0.15915494309189535f : 0.f;
        float g1[8], g2[8];
#pragma unroll
        for (int e = 0; e < 8; ++e) { g1[e] = ng ? ng[c1 + e] : 1.f; g2[e] = ng ? ng[c2 + e] : 1.f; }
        if (normtile) {
#pragma unroll
          for (int ai = 0; ai < 2; ++ai)
#pragma unroll
            for (int m = 0; m < 4; ++m) {
              float ss = 0.f;
#pragma unroll
              for (int bj = 0; bj < 2; ++bj)
#pragma unroll
                for (int n = 0; n < 2; ++n)
#pragma unroll
                  for (int j = 0; j < 4; ++j) ss += acc[ai][bj][m][n][j] * acc[ai][bj][m][n][j];
              ss += swz_xor<16>(ss); ss = half_sum(ss);
              if (fq == 0) xs[(rowl0 + ai * 128 + m * 16) * 4 + wc] = ss;
            }
          G_WAIT_L(0); G_BAR;
        }
        float rinv8[8];
#pragma unroll
        for (int q = 0; q < 8; ++q) {
          const int rl = rowl0 + (q >> 2) * 128 + (q & 3) * 16;
          rinv8[q] = normtile ? rsqrtf((xs[rl * 4 + wc] + xs[rl * 4 + (wc ^ 1)]) * (1.f / 128.f) + EPSV) : 1.f;
        }
#pragma unroll
        for (int e = 0; e < 8; ++e) { asm volatile("" : "+v"(g1[e])); asm volatile("" : "+v"(g2[e])); }
#pragma unroll
        for (int ai = 0; ai < 2; ++ai)
#pragma unroll
          for (int m = 0; m < 4; ++m) {
            const int rl = rowl0 + ai * 128 + m * 16;
            const int R = m0 + rl;
            float x1[8], x2[8];
#pragma unroll
            for (int n = 0; n < 2; ++n)
#pragma unroll
              for (int j = 0; j < 4; ++j) { x1[n * 4 + j] = acc[ai][0][m][n][j]; x2[n * 4 + j] = acc[ai][1][m][n][j]; }
            if (ng) {
              const float rinv = rinv8[ai * 4 + m];
#pragma unroll
              for (int e = 0; e < 8; ++e) { x1[e] = (x1[e] * rinv) * g1[e]; x2[e] = (x2[e] * rinv) * g2[e]; }
            }
            if (rope && !isctx) {
              const int tt = (R % TPB) - 256;
              const float pos = (float)(use_col ? (tt & 63) : (tt >> 6));
#pragma unroll
              for (int e = 0; e < 8; ++e) {
                float rev = pos * frev[e];
                rev = rev - floorf(rev);
                const float cs = __builtin_amdgcn_cosf(rev), sn = __builtin_amdgcn_sinf(rev);
                const float a = x1[e], bq = x2[e];
                x1[e] = a * cs - bq * sn; x2[e] = bq * cs + a * sn;
              }
            }
            if (silu) {
#pragma unroll
              for (int e = 0; e < 8; ++e) { x1[e] = x1[e] * __builtin_amdgcn_rcpf(1.f + fexp2(-LOG2E * x1[e])); x2[e] = x2[e] * __builtin_amdgcn_rcpf(1.f + fexp2(-LOG2E * x2[e])); }
            } else {
#pragma unroll
              for (int e = 0; e < 8; ++e) { x1[e] *= qmul; x2[e] *= qmul; }
            }
            u16* pp = p.P + (size_t)R * INW + n0 + head * 128;
            u32x4 o;
            o[0] = pack2(x1[0], x1[1]); o[1] = pack2(x1[2], x1[3]); o[2] = pack2(x1[4], x1[5]); o[3] = pack2(x1[6], x1[7]);
            *(u32x4*)(pp + c1) = o;
            o[0] = pack2(x2[0], x2[1]); o[1] = pack2(x2[2], x2[3]); o[2] = pack2(x2[4], x2[5]); o[3] = pack2(x2[6], x2[7]);
            *(u32x4*)(pp + c2) = o;
          }
      }
    }
    if (!has_next) break;
#pragma unroll
    for (int a = 0; a < 2; ++a)
#pragma unroll
      for (int b = 0; b < 2; ++b)
#pragma unroll
        for (int m = 0; m < 4; ++m)
#pragma unroll
          for (int n = 0; n < 2; ++n) acc[a][b][m][n] = (f32x4){0.f, 0.f, 0.f, 0.f};
    ct = ntn; cmt = nmt; cnt_ = nnt; ck0 = nk0; cnk = nnk; cA = nA; cB = nB; c32 = n32;
  }
  G_WAIT_V(0);
  if (wr == 0) G_BAR;
  G_BAR;
#undef G_SA
#undef G_SB
#undef G_STAGE
#undef G_LDA
#undef G_LDB
#undef G_MMA
#undef G_WAIT_V
#undef G_WAIT_L
#undef G_BAR
#undef G_SCHED
}

template <int PM> DI void attn_phase(const Params& p, int l, char* smem, int* s_item, int wv, int cidx) {
  int lane_; asm volatile("v_mbcnt_lo_u32_b32 %0, -1, 0\n\tv_mbcnt_hi_u32_b32 %0, -1, %0" : "=v"(lane_)); asm volatile("" : "+s"(wv));
  const int tid_ = wv * 64 + lane_;
  const int tid = tid_, lane = lane_, w = wv, h = lane >> 5, l31 = lane & 31;
  const int n_items = 512 + (l < 3 ? 64 : 0);
  char* Kb0 = smem;
  char* Vb0 = smem + 34816;
  float* rpb_s = (float*)(smem + 75776);
  float* sg_s = (float*)(smem + 77696);
  char* gate_s = smem + 78336;
  if (tid < 128) sg_s[tid] = p.subln_g[l * 128 + tid];
  const float li_ = (l == 0) ? 0.2f : (l == 1) ? 0.35550906759096926f : (l == 2) ? 0.47071301834358416f : 0.5560582041556405f;
  const float lambda_init = __uint_as_float(__builtin_amdgcn_readfirstlane(__float_as_uint(li_)));
  float lam;
  {
    float d1 = p.lq1[l * 64 + lane] * p.lk1[l * 64 + lane];
    float d2 = p.lq2[l * 64 + lane] * p.lk2[l * 64 + lane];
    d1 = wave_sum(d1); d2 = wave_sum(d2);
    lam = expf(d1) - expf(d2) + lambda_init;
    lam = __uint_as_float(__builtin_amdgcn_readfirstlane(__float_as_uint(lam)));
  }
  const int trow = tid >> 4, tch = tid & 15;
  if (tid == 0) *s_item = atomicAdd(p.counters + cidx, 1);
  for (;;) {
    __syncthreads();
    const int item = *s_item;
    if (item >= n_items) break;
    int nxt_item = 0;
    int mixer, b, head, qt; bool isctx;
    if (item < 512) {
      const int mo = item >> 7; mixer = (mo == 0) ? 0 : (mo == 1) ? 3 : (mo == 2) ? 2 : 1;
      const int rem = item & 127; b = rem >> 5; head = (rem >> 3) & 3; qt = rem & 7; isctx = false;
    } else {
      const int ci = item - 512; mixer = ci >> 4;
      const int rem = ci & 15; b = rem >> 2; head = rem & 3; qt = 0; isctx = true;
    }
    int qoff, koff, voff;
    if (mixer == 0) { qoff = head * 128; koff = 512 + head * 128; voff = 1024 + head * 128; }
    else if (mixer == 1) { qoff = 1536 + head * 128; koff = 2048 + (head >> 1) * 128; voff = 2304 + (head >> 1) * 128; }
    else if (mixer == 2) { qoff = 2560 + head * 128; koff = 3072 + head * 128; voff = 3584 + head * 128; }
    else { qoff = 4096 + head * 128; koff = 4608 + (head >> 1) * 128; voff = 4864 + (head >> 1) * 128; }
    const int Rb = b * TPB;
    const int Rq = Rb + (isctx ? 0 : 256) + qt * 256 + w * 32 + l31;
    int nplain, nlocal = 0, local_t0 = 0, mode = 0;
    if (isctx) nplain = 4;
    else if (mixer == 0 || mixer == 3) nplain = 36;
    else if (mixer == 1) {
      nplain = 4; mode = 1;
      const int ts = max(0, qt * 256 - 128), te = min(2048, qt * 256 + 384);
      local_t0 = ts; nlocal = (te - ts) >> 6;
    } else {
      nplain = 4; mode = 2;
      const int r0 = 4 * qt;
      const int lo = min(max(r0 - 4, 0), 24), hi = min(max(r0 - 1, 0), 24) + 8;
      local_t0 = lo * 64; nlocal = hi - lo;
    }
    const int ntl = nplain + nlocal;
    const int tq0 = qt * 256 + w * 32;
    const int tq = tq0 + l31;
    const int qrow = tq0 >> 6, qcol = tq & 63;
    const int kr0 = min(max(qrow - 4, 0), 24);
    const int cstart = min(max(qcol - 8, 0), 48);
    if (mode == 2) {
      if (tid < 465) rpb_s[tid] = p.rpb[(l * 4 + head) * 465 + tid] * LOG2E;
    }
    {
      const u16* gsrc = p.P + (size_t)(Rb + (isctx ? 0 : 256) + qt * 256 + (tid >> 4)) * INW + 5120 + mixer * 512 + head * 128 + (tid & 15) * 8;
      u32x4 gt[8];
#pragma unroll
      for (int j = 0; j < 8; ++j) gt[j] = *(const u32x4*)(gsrc + (size_t)j * 32 * INW);
#pragma unroll
      for (int j = 0; j < 8; ++j) *(u32x4*)(gate_s + ((tid >> 4) + 32 * j) * 264 + (tid & 15) * 16) = gt[j];
    }
    const int npass = (mixer == 0) ? 2 : 1;
    const bool full_d = (mixer != 0);
    float* asave = p.asave + (size_t)Rq * 512 + head * 128 + 4 * h;

    for (int pass = 0; pass < npass; ++pass) {
      bf16x8 qf[8];
      {
        const u16* qp = p.P + (size_t)Rq * INW + qoff + pass * 64 + h * 8;
#pragma unroll
        for (int ks = 0; ks < 4; ++ks) qf[ks] = *(const bf16x8*)(qp + ks * 16);
#pragma unroll
        for (int ks = 4; ks < 8; ++ks) qf[ks] = full_d ? *(const bf16x8*)(qp + ks * 16) : (bf16x8){0, 0, 0, 0, 0, 0, 0, 0};
      }
      const int dofs_b = pass * 128;
      f32x16 Oacc[4];
#pragma unroll
      for (int db = 0; db < 4; ++db)
#pragma unroll
        for (int e = 0; e < 16; ++e) Oacc[db][e] = 0.f;
      float m = -1e30f, lsum = 0.f;
      u32x4 kst[2], vst[2];
      __syncthreads();
      {
        const u16* base = p.P + (size_t)(Rb + trow) * INW + tch * 8;
#pragma unroll
        for (int j = 0; j < 2; ++j) {
          kst[j] = *(const u32x4*)(base + (size_t)j * 32 * INW + koff);
          vst[j] = *(const u32x4*)(base + (size_t)j * 32 * INW + voff);
        }
#pragma unroll
        for (int j = 0; j < 2; ++j) {
          *(u32x4*)(Kb0 + (trow + 32 * j) * 272 + tch * 16) = kst[j];
          *(u32x4*)(Vb0 + (trow + 32 * j) * 320 + tch * 16) = vst[j];
        }
        const int R1 = (1 < nplain) ? Rb + 64 : Rb + 256 + local_t0 + 64 * (1 - nplain);
        const u16* b1 = p.P + (size_t)(R1 + trow) * INW + tch * 8;
        if (ntl > 1) {
#pragma unroll
          for (int j = 0; j < 2; ++j) {
            kst[j] = *(const u32x4*)(b1 + (size_t)j * 32 * INW + koff);
            vst[j] = *(const u32x4*)(b1 + (size_t)j * 32 * INW + voff);
          }
        }
      }
      __syncthreads();
      const bool shift = ATT_SKEW && (w >= 4);
      bool pend = false;
      int vcur = 0;
      bf16x8 pf[2][2];
#pragma unroll
      for (int kb = 0; kb < 2; ++kb)
#pragma unroll
        for (int s2 = 0; s2 < 2; ++s2) pf[kb][s2] = (bf16x8){0, 0, 0, 0, 0, 0, 0, 0};
      const int vlane = (4 * h + ((lane & 15) >> 2)) * 320 + (16 * ((lane >> 4) & 1) + 4 * (lane & 3)) * 2;
#define ATT_VLO(VC, t) tr_read((VC) + ((((t) >> 1) & 1) * 32 + 16 * ((t) & 1)) * 320 + ((t) >> 2) * 64)
#define ATT_VHI(VC, t) tr_read((VC) + ((((t) >> 1) & 1) * 32 + 16 * ((t) & 1) + 8) * 320 + ((t) >> 2) * 64)
#define ATT_PV_PRE(VBUF) do { const char* Vc = Vb0 + (VBUF) * 20480 + vlane; \
        _Pragma("unroll") for (int t = 0; t < 1; ++t) { vlo[t] = ATT_VLO(Vc, t); vhi[t] = ATT_VHI(Vc, t); } } while (0)
#define ATT_PV_RUN(VBUF) do { const char* Vc = Vb0 + (VBUF) * 20480 + vlane; \
        _Pragma("unroll") for (int t = 1; t < 4; ++t) { vlo[t] = ATT_VLO(Vc, t); vhi[t] = ATT_VHI(Vc, t); } \
        _Pragma("unroll") for (int t = 0; t < 16; ++t) { \
          const bf16x8 vf = __builtin_shufflevector(vlo[t & 3], vhi[t & 3], 0, 1, 2, 3, 4, 5, 6, 7); \
          Oacc[t >> 2] = mfma32(vf, pf[(t >> 1) & 1][t & 1], Oacc[t >> 2]); \
          if (t + 4 < 16) { vlo[t & 3] = ATT_VLO(Vc, t + 4); vhi[t & 3] = ATT_VHI(Vc, t + 4); } \
          __builtin_amdgcn_sched_barrier(0); } } while (0)
#define ATT_PV(VBUF) do { s16x4 vlo[4], vhi[4]; ATT_PV_PRE(VBUF); ATT_PV_RUN(VBUF); } while (0)
      for (int i = 0; i < ntl; ++i) {
        const int cur = i & 1;
        const int vprev = vcur ^ 1, vnext = vcur ^ 1;
        const bool more = (i + 1 < ntl);
        if (PM != 2 && more) {
#pragma unroll
          for (int j = 0; j < 2; ++j) {
            *(u32x4*)(Kb0 + (cur ^ 1) * 17408 + (trow + 32 * j) * 272 + tch * 16) = kst[j];
            *(u32x4*)(Vb0 + vnext * 20480 + (trow + 32 * j) * 320 + tch * 16) = vst[j];
          }
        }
        if (PM != 2 && i + 2 < ntl) {
          const int inx = i + 2;
          const int Rn = (inx < nplain) ? Rb + 64 * inx : Rb + 256 + local_t0 + 64 * (inx - nplain);
          const u16* nbase = p.P + (size_t)(Rn + trow) * INW + tch * 8;
#pragma unroll
          for (int j = 0; j < 2; ++j) {
            kst[j] = *(const u32x4*)(nbase + (size_t)j * 32 * INW + koff);
            vst[j] = *(const u32x4*)(nbase + (size_t)j * 32 * INW + voff);
          }
        }
        __builtin_amdgcn_sched_barrier(0);
        if (shift && pend) { ATT_PV(vprev); pend = false; }
        bool active = (PM != 1);
        const int tpos = local_t0 + 64 * (i - nplain);
        if (i >= nplain) {
          if (mode == 1) active = (PM != 1) && (tpos + 63 >= tq0 - 128) && (tpos <= tq0 + 31 + 128);
          else { const int dr = (tpos >> 6) - kr0; active = (PM != 1) && (dr >= 0 && dr < 8); }
        }
        f32x16 sacc[2];
        if (active) {
#pragma unroll
          for (int kb = 0; kb < 2; ++kb)
#pragma unroll
            for (int e = 0; e < 16; ++e) sacc[kb][e] = 0.f;
          const char* Kc = Kb0 + cur * 17408 + l31 * 272 + dofs_b + h * 16;
          bf16x8 kf[8];
          if (full_d) {
#pragma unroll
            for (int j = 0; j < 8; ++j) kf[j] = *(const bf16x8*)(Kc + (j >> 3) * 32 * 272 + (j & 7) * 32);
#pragma unroll
            for (int j = 0; j < 16; ++j) {
              sacc[j >> 3] = mfma32(kf[j & 7], qf[j & 7], sacc[j >> 3]);
              if (j + 8 < 16) kf[j & 7] = *(const bf16x8*)(Kc + ((j + 8) >> 3) * 32 * 272 + ((j + 8) & 7) * 32);
              __builtin_amdgcn_sched_barrier(0);
            }
          } else {
#pragma unroll
            for (int j = 0; j < 4; ++j) kf[j] = *(const bf16x8*)(Kc + (j >> 2) * 32 * 272 + (j & 3) * 32);
#pragma unroll
            for (int j = 0; j < 8; ++j) {
              sacc[j >> 2] = mfma32(kf[j & 3], qf[j & 3], sacc[j >> 2]);
              if (j + 4 < 8) kf[j & 3] = *(const bf16x8*)(Kc + ((j + 4) >> 2) * 32 * 272 + ((j + 4) & 3) * 32);
              __builtin_amdgcn_sched_barrier(0);
            }
          }
        }
        s16x4 vlo[4], vhi[4];
        if (active && !shift) ATT_PV_PRE(vcur);
        if (active) {
          if (i >= nplain) {
            if (mode == 1) {
              const int dbase = tpos - tq + 4 * h;
#pragma unroll
              for (int kb = 0; kb < 2; ++kb)
#pragma unroll
                for (int e = 0; e < 16; ++e) {
                  const int d = dbase + kb * 32 + (e & 3) + 8 * (e >> 2);
                  sacc[kb][e] = (d <= 128 && d >= -128) ? sacc[kb][e] : -1e30f;
                }
            } else {
              const int kr = tpos >> 6;
              const int rbase = (kr - qrow + 7) * 31 + (15 - qcol);
#pragma unroll
              for (int kb = 0; kb < 2; ++kb)
#pragma unroll
                for (int e = 0; e < 16; ++e) {
                  const int kidx = kb * 32 + (e & 3) + 8 * (e >> 2) + 4 * h;
                  const int dc = kidx - cstart;
                  const bool valid = dc >= 0 && dc < 16;
                  const float bias = rpb_s[valid ? rbase + kidx : 0];
                  sacc[kb][e] = valid ? sacc[kb][e] + bias : -1e30f;
                }
            }
          }
          float mt = sacc[0][0];
#pragma unroll
          for (int e = 1; e < 16; ++e) mt = fmaxf(mt, sacc[0][e]);
#pragma unroll
          for (int e = 0; e < 16; ++e) mt = fmaxf(mt, sacc[1][e]);
          mt = half_max(mt);
          if (__builtin_amdgcn_ballot_w64(mt > m + 8.f) != 0ull) {
            const float mnew = fmaxf(m, mt);
            const float alpha = fexp2(m - mnew);
            m = mnew;
            lsum *= alpha;
#pragma unroll
            for (int db = 0; db < 4; ++db)
#pragma unroll
              for (int e = 0; e < 16; ++e) Oacc[db][e] *= alpha;
          }
          f2_t ps2 = {0.f, 0.f};
          const f2_t m2 = {m, m};
#pragma unroll
          for (int kb = 0; kb < 2; ++kb)
#pragma unroll
            for (int e = 0; e < 16; e += 2) {
              f2_t d = {sacc[kb][e], sacc[kb][e + 1]};
              d -= m2;
              f2_t pv = {fexp2(d[0]), fexp2(d[1])};
              ps2 += pv;
              sacc[kb][e] = pv[0]; sacc[kb][e + 1] = pv[1];
            }
          lsum += ps2[0] + ps2[1];
#pragma unroll
          for (int kb = 0; kb < 2; ++kb)
#pragma unroll
            for (int s2 = 0; s2 < 2; ++s2) {
              u32x4 t;
              t[0] = pack2(sacc[kb][8 * s2 + 0], sacc[kb][8 * s2 + 1]);
              t[1] = pack2(sacc[kb][8 * s2 + 2], sacc[kb][8 * s2 + 3]);
              t[2] = pack2(sacc[kb][8 * s2 + 4], sacc[kb][8 * s2 + 5]);
              t[3] = pack2(sacc[kb][8 * s2 + 6], sacc[kb][8 * s2 + 7]);
              pf[kb][s2] = __builtin_bit_cast(bf16x8, t);
            }
          if (!shift) ATT_PV_RUN(vcur); else pend = true;
        }
        vcur = vnext;
        __syncthreads();
      }
      if (shift && pend) { const int vlast = vcur ^ 1; ATT_PV(vlast); }
#undef ATT_PV
#undef ATT_PV_PRE
#undef ATT_PV_RUN
#undef ATT_VLO
#undef ATT_VHI
      if (pass == npass - 1 && tid == 0) nxt_item = atomicAdd(p.counters + cidx, 1);
      float lt = half_sum(lsum);
      if (mixer == 1) lt += fexp2(p.sink[l * 4 + head] * LOG2E - m);
      const float inv = 1.f / lt;
      float ov[4][16];
#pragma unroll
      for (int db = 0; db < 4; ++db)
#pragma unroll
        for (int e = 0; e < 16; ++e) ov[db][e] = Oacc[db][e] * inv;
      if (mixer == 0 && pass == 0) {
#pragma unroll
        for (int db = 0; db < 4; ++db)
#pragma unroll
          for (int g = 0; g < 4; ++g) {
            f32x4 o;
#pragma unroll
            for (int e = 0; e < 4; ++e) o[e] = ov[db][4 * g + e];
            *(f32x4*)(asave + db * 32 + 8 * g) = o;
          }
        continue;
      }
      float rr = 1.f;
      if (mixer == 0) {
        float ss = 0.f;
        const float* ap = asave;
#pragma unroll
        for (int db = 0; db < 4; ++db) {
          asm volatile("" : "+v"(ap), "+v"(ss));
#pragma unroll
          for (int g = 0; g < 4; ++g) {
            const f32x4 sv = *(const f32x4*)(ap + db * 32 + 8 * g);
#pragma unroll
            for (int e = 0; e < 4; ++e) { const float o = sv[e] - lam * ov[db][4 * g + e]; ov[db][4 * g + e] = o; ss += o * o; }
          }
        }
        ss = half_sum(ss);
        rr = rsqrtf(ss * (1.f / 128.f) + EPSV) * (1.f - lambda_init);
      }
      {
        const char* gl = gate_s + (w * 32 + l31) * 264 + 8 * h;
        u16* op = p.O + (size_t)Rq * DM + mixer * 512 + head * 128 + 4 * h;
        const float* sg = sg_s + 4 * h;
#pragma unroll
        for (int db = 0; db < 4; ++db)
#pragma unroll
          for (int g = 0; g < 4; ++g) {
            const int d = db * 32 + 8 * g;
            f32x4 sv = {1.f, 1.f, 1.f, 1.f};
            if (mixer == 0) sv = *(const f32x4*)(sg + d);
            const u32x2 gv = *(const u32x2*)(gl + d * 2);
            u32x2 o;
            o[0] = pack2(ov[db][4 * g + 0] * rr * sv[0] * bf_lo(gv[0]), ov[db][4 * g + 1] * rr * sv[1] * bf_hi(gv[0]));
            o[1] = pack2(ov[db][4 * g + 2] * rr * sv[2] * bf_lo(gv[1]), ov[db][4 * g + 3] * rr * sv[3] * bf_hi(gv[1]));
            *(u32x2*)(op + d) = o;
          }
      }
    }
    if (tid == 0) *s_item = nxt_item;
  }
}

#define XB_TMO      128
#define XB_XCNT(j)  (256  + 64 * (j))
#define XB_XSUB(j)  (1280 + 64 * (j))
#define XB_XGEN(j)  (2304 + 64 * (j))
#define XB_TOP      3328
#define XB_TOPGEN   3392
#define XCD_BAR_WORDS 3456
#define XB_SPIN_CAP (1u << 20)
DI unsigned xb_ld(unsigned* p)              { return __hip_atomic_load(p, __ATOMIC_RELAXED, __HIP_MEMORY_SCOPE_AGENT); }
DI unsigned xb_add(unsigned* p, unsigned v) { return __hip_atomic_fetch_add(p, v, __ATOMIC_RELAXED, __HIP_MEMORY_SCOPE_AGENT); }
DI unsigned xb_xcc_id() { return (unsigned)__builtin_amdgcn_s_getreg((3 << 11) | 20) & 0xFu; }
#define XB_SPIN(cond, bar) do { unsigned _sp = 0; while (cond) { __builtin_amdgcn_s_sleep(1); \
    if ((++_sp & 255u) == 0u) { if (xb_ld(&(bar)[XB_TMO])) break; if (_sp > XB_SPIN_CAP) { atomicAdd(&(bar)[XB_TMO], 1u); break; } } } } while (0)
DI void xcd_barrier_complete(unsigned* bar, unsigned x, unsigned& nloc, unsigned& nx) {
  const unsigned G = gridDim.x;
  unsigned sum, cnt, mine, sp = 0u;
  for (;;) {
    sum = 0u; cnt = 0u; mine = 0u;
#pragma unroll
    for (unsigned j = 0; j < 16; ++j) { const unsigned c = xb_ld(&bar[XB_XCNT(j)]); sum += c; cnt += (c > 0u) ? 1u : 0u; mine = (j == x) ? c : mine; }
    if (sum == G) break;
    __builtin_amdgcn_s_sleep(1);
    if ((++sp & 255u) == 0u) { if (xb_ld(&bar[XB_TMO])) break; if (sp > XB_SPIN_CAP) { atomicAdd(&bar[XB_TMO], 1u); break; } }
  }
  nloc = mine > 0u ? mine : 1u; nx = cnt > 0u ? cnt : 1u;
}
DI bool xb_leader_lane(int wv) {
  int lane_; asm volatile("v_mbcnt_lo_u32_b32 %0, -1, 0\n\tv_mbcnt_hi_u32_b32 %0, -1, %0" : "=v"(lane_));
  return wv == 0 && lane_ == 0;
}
DI void xcd_barrier(unsigned* bar, volatile LAS unsigned* st, int wv) {
  asm volatile("s_waitcnt vmcnt(0)" ::: "memory");
  __syncthreads();
  if (xb_leader_lane(wv)) {
    __builtin_amdgcn_s_waitcnt(0);
    const unsigned x = xb_xcc_id();
    unsigned nloc = st[0], nx = st[1];
    if (nloc == 0u) { xcd_barrier_complete(bar, x, nloc, nx); st[0] = nloc; st[1] = nx; }
    const unsigned old = xb_add(&bar[XB_XSUB(x)], 1u);
    const unsigned gen = old / nloc;
    if (old + 1u == (gen + 1u) * nloc) {
      __builtin_amdgcn_fence(__ATOMIC_RELEASE, "agent");
      asm volatile("s_waitcnt vmcnt(0)" ::: "memory");
      const unsigned og = xb_add(&bar[XB_TOP], 1u);
      const unsigned tg = og / nx;
      if (og + 1u == (tg + 1u) * nx) xb_add(&bar[XB_TOPGEN], 1u);
      else XB_SPIN(xb_ld(&bar[XB_TOPGEN]) == tg, bar);
      __builtin_amdgcn_fence(__ATOMIC_ACQUIRE, "agent");
      xb_add(&bar[XB_XGEN(x)], 1u);
      asm volatile("s_waitcnt vmcnt(0)" ::: "memory");
    } else {
      XB_SPIN(xb_ld(&bar[XB_XGEN(x)]) == gen, bar);
      __builtin_amdgcn_fence(__ATOMIC_ACQUIRE, "agent");
      asm volatile("s_waitcnt vmcnt(0)" ::: "memory");
    }
  }
  __syncthreads();
}

__global__ void __launch_bounds__(512, 1) mega_kernel(Params p) {
  __shared__ __attribute__((aligned(16))) char smem[SMEM_BYTES + 16];
  int* s_item_p = (int*)(smem + SMEM_BYTES);
  volatile LAS unsigned* xb_st = (volatile LAS unsigned*)(smem + SMEM_BYTES + 8);
  cg::grid_group grid = cg::this_grid();
  const int wv = __builtin_amdgcn_readfirstlane(threadIdx.x >> 6);
  if (xb_leader_lane(wv)) { xb_st[0] = 0u; xb_st[1] = 0u; (void)xb_add(&p.bar[XB_XCNT(xb_xcc_id())], 1u); }
  __syncthreads();
  for (int ph = p.phase_lo; ph <= p.phase_hi; ++ph) {
    if (ph == p.phase_lo + 1) grid.sync();
    else if (ph > p.phase_lo + 1) xcd_barrier(p.bar, xb_st, wv);
#pragma unroll 1
    for (int rep = 0; rep < 2; ++rep) {
      if (rep == 1) {
        const bool dup = (DUP_SUB == -2) ? (ph == 0) : (ph >= 3 && ((ph - 3) & 3) == DUP_SUB);
        if (!dup) break;
        grid.sync();
      }
      if (ph == 0) phase0(p, smem, wv);
      else if (ph == 1) phase1(p, wv);
      else if (ph == 2) rowpass(p, 0, true, wv, smem);
      else {
        const int l = (ph - 3) >> 2, sub = (ph - 3) & 3;
        if (sub == 0) { if (DUP_SUB == 0 && rep == 0) gemm_phase<GEMM_PROBE>(p, l, 0, smem, wv); else gemm_phase<0>(p, l, 0, smem, wv); }
        else if (sub == 2) gemm_phase<0>(p, l, 1, smem, wv);
        else if (sub == 1) { if (DUP_SUB == 1 && rep == 0) attn_phase<ATT_PROBE>(p, l, smem, s_item_p, wv, l + 4); else attn_phase<0>(p, l, smem, s_item_p, wv, l); }
        else rowpass(p, l, false, wv, smem);
      }
    }
  }
}

extern "C" void kernel_launch(void* const* d_in, const int* in_sizes, int n_in, void* d_out, int out_size,
                              void* d_ws, size_t ws_size, hipStream_t stream) {
  Params p{};
  p.x = (const float*)d_in[0]; p.c = (const float*)d_in[1]; p.ctx = (const float*)d_in[2]; p.c_ctx = (const float*)d_in[3];
  p.w_mod = (const float*)d_in[4]; p.b_mod = (const float*)d_in[5]; p.pre_g = (const float*)d_in[6]; p.w_in = (const float*)d_in[7];
  p.lq1 = (const float*)d_in[8]; p.lk1 = (const float*)d_in[9]; p.lq2 = (const float*)d_in[10]; p.lk2 = (const float*)d_in[11];
  p.subln_g = (const float*)d_in[12]; p.sink = (const float*)d_in[13]; p.rpb = (const float*)d_in[14];
  p.gq = (const float*)d_in[15]; p.gk = (const float*)d_in[16]; p.w_out = (const float*)d_in[17]; p.post_g = (const float*)d_in[18];
  p.out = (float*)d_out;
  char* ws = (char*)d_ws;
  size_t off = 0;
  auto carve = [&](size_t bytes) { char* r = ws + off; off += (bytes + 255) & ~(size_t)255; return r; };
  p.wt_in = (u16*)carve((size_t)4 * INW * DM * 2);
  p.wt_out = (u16*)carve((size_t)4 * DM * DM * 2);
  p.nbuf = (u16*)carve((size_t)NTOK * DM * 2);
  p.P = (u16*)carve((size_t)NTOK * INW * 2);
  p.O = (u16*)carve((size_t)NTOK * DM * 2);
  p.y = (u16*)carve((size_t)NTOK * DM * 2);
  p.ypart = (u16*)carve((size_t)8 * 1024 * DM * 2);
  p.hc = (float*)carve((size_t)1024 * DM * 4);
  p.modpart = (float*)carve((size_t)16 * 4 * 30720 * 4);
  p.mod = (float*)carve((size_t)4 * 30720 * 4);
  p.rope128 = (float*)carve((size_t)2048 * 64 * 2 * 4);
  p.rope64 = (float*)carve((size_t)2048 * 32 * 2 * 4);
  p.asave = (float*)carve((size_t)NTOK * 512 * 4);
  p.counters = (int*)carve(256);
  p.bar = (unsigned*)carve((size_t)XCD_BAR_WORDS * 4);
  p.phase_lo = 0; p.phase_hi = 18;
  static int grid_blocks = 0;
  if (!grid_blocks) {
    int dev = 0, cus = 0, per_cu = 0;
    (void)hipGetDevice(&dev);
    (void)hipDeviceGetAttribute(&cus, hipDeviceAttributeMultiprocessorCount, dev);
    (void)hipOccupancyMaxActiveBlocksPerMultiprocessor(&per_cu, mega_kernel, NTHR, 0);
    if (per_cu > 1) per_cu = 1;
    if (per_cu < 1) per_cu = 1;
    grid_blocks = cus * per_cu;
  }
  (void)hipMemsetAsync(p.bar, 0, (size_t)XCD_BAR_WORDS * 4, stream);
  void* args[] = {&p};
  hipError_t e = hipLaunchCooperativeKernel((void*)mega_kernel, dim3(grid_blocks), dim3(NTHR), args, 0, stream);
  if (e != hipSuccess) fprintf(stderr, "cooperative launch failed: %s (grid %d)\n", hipGetErrorString(e), grid_blocks);
}
```

```cpp
#include <hip/hip_runtime.h>
#include <hip/hip_cooperative_groups.h>
#include <cstdio>
namespace cg = cooperative_groups;

#define DI __device__ __forceinline__
typedef short bf16x8 __attribute__((ext_vector_type(8)));
typedef short s16x4 __attribute__((ext_vector_type(4)));
typedef float f32x16 __attribute__((ext_vector_type(16)));
typedef float f32x4 __attribute__((ext_vector_type(4)));
typedef unsigned u32x4 __attribute__((ext_vector_type(4)));
typedef unsigned u32x2 __attribute__((ext_vector_type(2)));
typedef __bf16 bf2_t __attribute__((ext_vector_type(2)));
typedef float f2_t __attribute__((ext_vector_type(2)));
typedef unsigned short u16;

constexpr int DM = 2048;
constexpr int TPB = 2304;
constexpr int NTOK = 9216;
constexpr int INW = 7168;
constexpr int SMEM_BYTES = 147456;
constexpr int NTHR = 512;
constexpr int GEMM_PROBE = 0;
constexpr int ATT_PROBE = 0;
constexpr bool ATT_SKEW = false;
constexpr int DUP_SUB = -1;
constexpr float LOG2E = 1.4426950408889634f;
constexpr float EPSV = 1e-6f;

struct Params {
  const float *x, *c, *ctx, *c_ctx, *w_mod, *b_mod, *pre_g, *w_in, *lq1, *lk1, *lq2, *lk2, *subln_g, *sink, *rpb, *gq, *gk, *w_out, *post_g;
  float* out;
  u16 *wt_in, *wt_out, *nbuf, *P, *O;
  float *hc, *modpart, *mod, *rope128, *rope64, *asave;
  u16 *y, *ypart;
  int* counters;
  unsigned* bar;
  int phase_lo, phase_hi;
};

DI unsigned pack2(float a, float b) { f2_t v = {a, b}; bf2_t r = __builtin_convertvector(v, bf2_t); return __builtin_bit_cast(unsigned, r); }
DI float bf_lo(unsigned u) { return __uint_as_float(u << 16); }
DI float bf_hi(unsigned u) { return __uint_as_float(u & 0xffff0000u); }
DI float fexp2(float x) { return __builtin_amdgcn_exp2f(x); }
DI f32x16 mfma32(bf16x8 a, bf16x8 b, f32x16 c) { return __builtin_amdgcn_mfma_f32_32x32x16_bf16(a, b, c, 0, 0, 0); }
template <int K> DI float swz_xor(float v) { return __uint_as_float(__builtin_amdgcn_ds_swizzle(__float_as_uint(v), (K << 10) | 0x1f)); }
DI float half_sum(float v) { const auto r = __builtin_amdgcn_permlane32_swap(__float_as_uint(v), __float_as_uint(v), false, false); return __uint_as_float(r[0]) + __uint_as_float(r[1]); }
DI float half_max(float v) { const auto r = __builtin_amdgcn_permlane32_swap(__float_as_uint(v), __float_as_uint(v), false, false); return fmaxf(__uint_as_float(r[0]), __uint_as_float(r[1])); }
DI float wave_sum(float v) {
  v = half_sum(v);
  v += swz_xor<16>(v); v += swz_xor<8>(v); v += swz_xor<4>(v); v += swz_xor<2>(v); v += swz_xor<1>(v);
  return v;
}
DI s16x4 tr_read(const char* p) {
  return __builtin_amdgcn_ds_read_tr16_b64_v4i16((s16x4 __attribute__((address_space(3)))*)(p));
}

DI void phase0(const Params& p, char* smem, int wv) {
  int lane_; asm volatile("v_mbcnt_lo_u32_b32 %0, -1, 0\n\tv_mbcnt_hi_u32_b32 %0, -1, %0" : "=v"(lane_)); asm volatile("" : "+s"(wv));
  const int tid_ = wv * 64 + lane_;
  const int tid = tid_, lane = lane_, w = wv;
  if (blockIdx.x == 0 && tid < 8) p.counters[tid] = 0;
  constexpr int N_MOD = 192, N_TRIN = 3584, N_TROUT = 1024, N_ROPE = 0;
  float* sf = (float*)smem;
  for (int it = blockIdx.x; it < N_MOD; it += gridDim.x) {
    const int l = it / 48, rem = it % 48, kc = rem / 3, cg4 = rem % 3;
    for (int idx = tid; idx < 640; idx += NTHR) {
      const int r = idx >> 7, k = idx & 127;
      const float v = (r < 4) ? p.c[r * DM + kc * 128 + k] : p.c_ctx[kc * 128 + k];
      sf[idx] = v / (1.f + __expf(-v));
    }
    __syncthreads();
    const int col = (cg4 * 8 + w) * 256 + lane * 4;
    const float* wp = p.w_mod + ((size_t)l * DM + kc * 128) * 6144 + col;
    f32x4 a0 = {0, 0, 0, 0}, a1 = a0, a2 = a0, a3 = a0, a4 = a0;
#pragma unroll 16
    for (int k = 0; k < 128; ++k) {
      const f32x4 wvv = *(const f32x4*)(wp + (size_t)k * 6144);
      a0 += sf[k] * wvv; a1 += sf[128 + k] * wvv; a2 += sf[256 + k] * wvv; a3 += sf[384 + k] * wvv; a4 += sf[512 + k] * wvv;
    }
    float* mp = p.modpart + (size_t)(kc * 4 + l) * 30720 + col;
    *(f32x4*)(mp) = a0; *(f32x4*)(mp + 6144) = a1; *(f32x4*)(mp + 2 * 6144) = a2;
    *(f32x4*)(mp + 3 * 6144) = a3; *(f32x4*)(mp + 4 * 6144) = a4;
    __syncthreads();
  }
  {
    constexpr int N_TR = N_TRIN + N_TROUT;
    auto tr_desc = [&](int ti, const float*& src, u16*& dst, int& N, int& kt, int& nt) {
      if (ti < N_TRIN) {
        const int l = ti / 896, rem = ti % 896; kt = rem / 56; nt = rem % 56; N = INW;
        src = p.w_in + (size_t)l * DM * INW; dst = p.wt_in + (size_t)l * INW * DM;
      } else {
        const int t2 = ti - N_TRIN;
        const int l = t2 / 256, rem = t2 % 256; kt = rem / 16; nt = rem % 16; N = DM;
        src = p.w_out + (size_t)l * DM * DM; dst = p.wt_out + (size_t)l * DM * DM;
      }
    };
    const int row0 = tid >> 5, c4 = (tid & 31) * 4;
    const int g = gridDim.x;
    int ti = (blockIdx.x + g - (N_MOD % g)) % g;
    f32x4 v[8];
    const float* src; u16* dst; int N, kt, nt;
    if (ti < N_TR) {
      tr_desc(ti, src, dst, N, kt, nt);
#pragma unroll
      for (int i = 0; i < 8; ++i) v[i] = *(const f32x4*)(src + (size_t)(kt * 128 + row0 + 16 * i) * N + nt * 128 + c4);
    }
    for (; ti < N_TR; ti += g) {
#pragma unroll
      for (int i = 0; i < 8; ++i) {
        float* d = sf + (row0 + 16 * i) * 129 + c4;
        d[0] = v[i][0]; d[1] = v[i][1]; d[2] = v[i][2]; d[3] = v[i][3];
      }
      __syncthreads();
      u16* dcur = dst; const int ktc = kt, ntc = nt;
      if (ti + g < N_TR) {
        tr_desc(ti + g, src, dst, N, kt, nt);
#pragma unroll
        for (int i = 0; i < 8; ++i) v[i] = *(const f32x4*)(src + (size_t)(kt * 128 + row0 + 16 * i) * N + nt * 128 + c4);
      }
#pragma unroll
      for (int i = 0; i < 4; ++i) {
        const int n = (tid >> 4) + 32 * i, k8 = (tid & 15) * 8;
        u32x4 o;
        o[0] = pack2(sf[(k8 + 0) * 129 + n], sf[(k8 + 1) * 129 + n]);
        o[1] = pack2(sf[(k8 + 2) * 129 + n], sf[(k8 + 3) * 129 + n]);
        o[2] = pack2(sf[(k8 + 4) * 129 + n], sf[(k8 + 5) * 129 + n]);
        o[3] = pack2(sf[(k8 + 6) * 129 + n], sf[(k8 + 7) * 129 + n]);
        *(u32x4*)(dcur + (size_t)(ntc * 128 + n) * DM + ktc * 128 + k8) = o;
      }
      __syncthreads();
    }
  }
}

DI void phase1(const Params& p, int wv) {
  int lane_; asm volatile("v_mbcnt_lo_u32_b32 %0, -1, 0\n\tv_mbcnt_hi_u32_b32 %0, -1, %0" : "=v"(lane_)); asm volatile("" : "+s"(wv));
  const int tid_ = wv * 64 + lane_;
  for (int idx = blockIdx.x * NTHR + tid_; idx < 4 * 30720; idx += gridDim.x * NTHR) {
    const int l = idx / 30720, rem = idx % 30720, col = rem % 6144;
    float s = p.b_mod[l * 6144 + col];
#pragma unroll
    for (int kc = 0; kc < 16; ++kc) s += p.modpart[(size_t)(kc * 4 + l) * 30720 + rem];
    p.mod[idx] = s;
  }
}

DI void rowpass(const Params& p, int l, bool first, int wv, char* smem) {
  int lane_; asm volatile("v_mbcnt_lo_u32_b32 %0, -1, 0\n\tv_mbcnt_hi_u32_b32 %0, -1, %0" : "=v"(lane_)); asm volatile("" : "+s"(wv));
  const int tid_ = wv * 64 + lane_;
  const int lane = lane_, w = wv;
  const int lnext = first ? 0 : l + 1;
  float* lg_post = (float*)smem;
  float* lg_pre = (float*)smem + 2048;
  {
    const int t4 = (wv * 64 + lane_) * 4;
    if (!first) *(f32x4*)(lg_post + t4) = *(const f32x4*)(p.post_g + l * DM + t4);
    if (first || l < 3) *(f32x4*)(lg_pre + t4) = *(const f32x4*)(p.pre_g + lnext * DM + t4);
    __syncthreads();
  }
  for (int R = blockIdx.x * 8 + w; R < NTOK; R += gridDim.x * 8) {
    const int b = R / TPB, j = R - b * TPB;
    const bool isctx = j < 256;
    const int mr = isctx ? 4 : b;
    if (!first && l == 3 && isctx) continue;
    const float* hin; float* hout;
    if (isctx) {
      hout = p.hc + (size_t)(b * 256 + j) * DM;
      hin = (first || l == 0) ? p.ctx + (size_t)(b * 256 + j) * DM : hout;
    } else {
      hout = p.out + (size_t)(b * 2048 + (j - 256)) * DM;
      hin = (first || l == 0) ? p.x + (size_t)(b * 2048 + (j - 256)) * DM : hout;
    }
    f32x4 hv[8];
#pragma unroll
    for (int i = 0; i < 8; ++i) hv[i] = *(const f32x4*)(hin + i * 256 + lane * 4);
    if (!first) {
      f32x4 yv[8];
      float ss = 0.f;
      if (!isctx) {
        const u16* yp = p.y + (size_t)R * DM;
#pragma unroll
        for (int i = 0; i < 8; ++i) {
          const u32x2 u = *(const u32x2*)(yp + i * 256 + lane * 4);
          yv[i][0] = bf_lo(u[0]); yv[i][1] = bf_hi(u[0]); yv[i][2] = bf_lo(u[1]); yv[i][3] = bf_hi(u[1]);
        }
      } else {
#pragma unroll
        for (int i = 0; i < 8; ++i) yv[i] = (f32x4){0.f, 0.f, 0.f, 0.f};
#pragma unroll
        for (int kc = 0; kc < 8; ++kc) {
          const u16* yp = p.ypart + ((size_t)kc * 1024 + (size_t)(b * 256 + j)) * DM;
#pragma unroll
          for (int i = 0; i < 8; ++i) {
            const u32x2 u = *(const u32x2*)(yp + i * 256 + lane * 4);
            yv[i][0] += bf_lo(u[0]); yv[i][1] += bf_hi(u[0]); yv[i][2] += bf_lo(u[1]); yv[i][3] += bf_hi(u[1]);
          }
        }
      }
#pragma unroll
      for (int i = 0; i < 8; ++i) ss += yv[i][0] * yv[i][0] + yv[i][1] * yv[i][1] + yv[i][2] * yv[i][2] + yv[i][3] * yv[i][3];
      const float* gate = p.mod + (size_t)(l * 5 + mr) * 6144 + 4096;
      f32x4 gtv[8];
#pragma unroll
      for (int i = 0; i < 8; ++i) gtv[i] = *(const f32x4*)(gate + i * 256 + lane * 4);
      f32x4 shv[8], scv[8];
      if (l < 3) {
        const float* shift = p.mod + (size_t)(lnext * 5 + mr) * 6144;
#pragma unroll
        for (int i = 0; i < 8; ++i) { shv[i] = *(const f32x4*)(shift + i * 256 + lane * 4); scv[i] = *(const f32x4*)(shift + 2048 + i * 256 + lane * 4); }
      }
      ss = wave_sum(ss);
      const float r1 = rsqrtf(ss * (1.f / DM) + EPSV);
#pragma unroll
      for (int i = 0; i < 8; ++i) {
        const f32x4 gpv = *(const f32x4*)(lg_post + i * 256 + lane * 4);
#pragma unroll
        for (int e = 0; e < 4; ++e) hv[i][e] += gtv[i][e] * ((yv[i][e] * r1) * gpv[e]);
        *(f32x4*)(hout + i * 256 + lane * 4) = hv[i];
      }
      if (l < 3) {
        float s2 = 0.f;
#pragma unroll
        for (int i = 0; i < 8; ++i) s2 += hv[i][0] * hv[i][0] + hv[i][1] * hv[i][1] + hv[i][2] * hv[i][2] + hv[i][3] * hv[i][3];
        s2 = wave_sum(s2);
        const float r2 = rsqrtf(s2 * (1.f / DM) + EPSV);
        u16* np = p.nbuf + (size_t)R * DM;
#pragma unroll
        for (int i = 0; i < 8; ++i) {
          const f32x4 grv = *(const f32x4*)(lg_pre + i * 256 + lane * 4);
          float o[4];
#pragma unroll
          for (int e = 0; e < 4; ++e) o[e] = ((hv[i][e] * r2) * grv[e]) * (1.f + scv[i][e]) + shv[i][e];
          u32x2 pk; pk[0] = pack2(o[0], o[1]); pk[1] = pack2(o[2], o[3]);
          *(u32x2*)(np + i * 256 + lane * 4) = pk;
        }
      }
      continue;
    }
    {
      float ss = 0.f;
#pragma unroll
      for (int i = 0; i < 8; ++i) ss += hv[i][0] * hv[i][0] + hv[i][1] * hv[i][1] + hv[i][2] * hv[i][2] + hv[i][3] * hv[i][3];
      ss = wave_sum(ss);
      const float r2 = rsqrtf(ss * (1.f / DM) + EPSV);
      const float* shift = p.mod + (size_t)(lnext * 5 + mr) * 6144;
      const float* scale = shift + 2048;
      const float* gpre = p.pre_g + lnext * DM;
      u16* np = p.nbuf + (size_t)R * DM;
#pragma unroll
      for (int i = 0; i < 8; ++i) {
        const f32x4 sh = *(const f32x4*)(shift + i * 256 + lane * 4);
        const f32x4 sc = *(const f32x4*)(scale + i * 256 + lane * 4);
        const f32x4 gp = *(const f32x4*)(gpre + i * 256 + lane * 4);
        float o[4];
#pragma unroll
        for (int e = 0; e < 4; ++e) o[e] = ((hv[i][e] * r2) * gp[e]) * (1.f + sc[e]) + sh[e];
        u32x2 pk; pk[0] = pack2(o[0], o[1]); pk[1] = pack2(o[2], o[3]);
        *(u32x2*)(np + i * 256 + lane * 4) = pk;
      }
    }
  }
}

#define LAS __attribute__((address_space(3)))
constexpr int G_HTB = 128 * 64 * 2;
DI int lds_byte(int r, int c) { const int stt = (r >> 4) * 2 + (c >> 5), rr = r & 15, cc = c & 31, ob = rr * 64 + cc * 2; return stt * 1024 + (ob ^ (((ob >> 9) & 1) << 5)); }
DI void stage_rc(int b, int& R, int& C) { const int stt = b / 1024, sb = b % 1024, swz = sb ^ (((sb >> 9) & 1) << 5); R = (stt >> 1) * 16 + swz / 64; C = (stt & 1) * 32 + (swz % 64) / 2; }

template <int GP> DI void gemm_phase(const Params& p, int l, int which, char* smem, int wv) {
  int lane_; asm volatile("v_mbcnt_lo_u32_b32 %0, -1, 0\n\tv_mbcnt_hi_u32_b32 %0, -1, %0" : "=v"(lane_)); asm volatile("" : "+s"(wv));
  const int lane = lane_, wid = wv, tid = wid * 64 + lane, wr = wid >> 2, wc = wid & 3, fr = lane & 15, fq = lane >> 4;
  LAS unsigned char* lds = (LAS unsigned char*)smem;
  float* xs = (float*)(smem + 8 * G_HTB);
  const u16* Aglob = which ? p.O : p.nbuf;
  const u16* Wt = which ? p.wt_out + (size_t)l * DM * DM : p.wt_in + (size_t)l * INW * DM;
  const int NT = which ? 8 : 28;
  const int NH = NT >> 1;
  const int chunk = which ? 64 : 9 * NH;
  const int xcd = blockIdx.x & 7, nbx = gridDim.x >> 3;
  constexpr int K = DM;
  auto unit_ok = [&](int t, int& mt, int& nt, int& k0, int& nk) -> bool {
    if (which) {
      const int bb = xcd >> 1, nh = xcd & 1;
      if (t < 32) { mt = bb * 9 + 1 + (t & 7); nt = nh * 4 + (t >> 3); k0 = 0; nk = 32; return true; }
      if (l == 3) return false;
      const int c = t - 32; mt = bb * 9; nt = nh * 4 + (c >> 3); k0 = (c & 7) * 256; nk = 4; return true;
    }
    mt = (xcd >> 1) * 9 + (t % 9); nt = (xcd & 1) * NH + t / 9; k0 = 0; nk = 32;
    if (l == 3 && (mt % 9) == 0)
      return (nt >= 2 && nt < 6) || (nt >= 8 && nt < 10) || (nt >= 12 && nt < 16) || (nt >= 18 && nt < 20);
    return true;
  };
  auto next_unit = [&](int t, int& mt, int& nt, int& k0, int& nk) -> int {
    for (t += nbx; t < chunk; t += nbx) if (unit_ok(t, mt, nt, k0, nk)) return t;
    return -1;
  };
  unsigned voffA[2];
#pragma unroll
  for (int i = 0; i < 2; ++i) { int R, C; stage_rc(tid * 16 + i * 8192, R, C); voffA[i] = (unsigned)(R * K + C) * 2u; }
  auto voffB = [&](int i, int hf, bool m32) -> unsigned {
    int t2 = tid; asm volatile("" : "+v"(t2));
    int R, C; stage_rc(t2 * 16 + i * 8192, R, C);
    const int swc = R >> 5, sn = (R >> 4) & 1, sfq = (R >> 2) & 3, sj = R & 3;
    const int c = m32 ? ((swc >> 1) * 128 + (swc & 1) * 64 + hf * 32 + sfq * 8 + sn * 4 + sj)
                      : ((swc >> 1) * 128 + hf * 64 + (swc & 1) * 32 + sfq * 8 + sn * 4 + sj);
    return (unsigned)(c * K + C) * 2u;
  };
  const size_t kstep = 128;
  const size_t hstep = (size_t)128 * K * 2;
  const size_t tstep = 2 * hstep;
  const unsigned ldsw = (unsigned)wid * 1024u;
  const int aoff = lds_byte(wr * 64 + fr, fq * 8), boff = lds_byte(wc * 32 + fr, fq * 8);
#define G_SA(b, h) (((b) * 2 + (h)) * G_HTB)
#define G_SB(b, h) ((4 + (b) * 2 + (h)) * G_HTB)
#define G_STAGE(bufoff, gbase, voff) do { _Pragma("unroll") for (int _i = 0; _i < 2; ++_i) \
    __builtin_amdgcn_global_load_lds((const unsigned*)((const char*)(gbase) + (voff)[_i]), (LAS unsigned*)(lds + (bufoff) + ldsw + _i * 8192), 16, 0, 0); } while (0)
#define G_LDA(dst, b, h) do { _Pragma("unroll") for (int m = 0; m < 4; ++m) _Pragma("unroll") for (int k = 0; k < 2; ++k) dst[m][k] = *(const LAS bf16x8*)(lds + G_SA(b, h) + aoff + m * 2048 + k * 1024); } while (0)
#define G_LDB(dst, b, h) do { _Pragma("unroll") for (int n = 0; n < 2; ++n) _Pragma("unroll") for (int k = 0; k < 2; ++k) dst[n][k] = *(const LAS bf16x8*)(lds + G_SB(b, h) + boff + n * 2048 + k * 1024); } while (0)
#define G_MMA(ai, bj, At, Bt) do { __builtin_amdgcn_s_setprio(1); _Pragma("unroll") for (int m = 0; m < 4; ++m) _Pragma("unroll") for (int n = 0; n < 2; ++n) _Pragma("unroll") for (int k = 0; k < 2; ++k) \
    acc[ai][bj][m][n] = __builtin_amdgcn_mfma_f32_16x16x32_bf16(Bt[n][k], At[m][k], acc[ai][bj][m][n], 0, 0, 0); __builtin_amdgcn_s_setprio(0); } while (0)
#define G_WAIT_V(n) asm volatile("s_waitcnt vmcnt(" #n ")" ::: "memory")
#define G_WAIT_L(n) asm volatile("s_waitcnt lgkmcnt(" #n ")" ::: "memory")
#define G_BAR __builtin_amdgcn_s_barrier()
#define G_SCHED __builtin_amdgcn_sched_barrier(0)
  int cmt, cnt_, ck0, cnk, nmt = 0, nnt = 0, nk0 = 0, nnk = 32;
  int ct = next_unit((blockIdx.x >> 3) - nbx, cmt, cnt_, ck0, cnk);
  if (ct < 0) return;
  f32x4 acc[2][2][4][2];
#pragma unroll
  for (int a = 0; a < 2; ++a)
#pragma unroll
    for (int b = 0; b < 2; ++b)
#pragma unroll
      for (int m = 0; m < 4; ++m)
#pragma unroll
        for (int n = 0; n < 2; ++n) acc[a][b][m][n] = (f32x4){0.f, 0.f, 0.f, 0.f};
  bf16x8 At[4][2], B0[2][2], B1[2][2];
  const char* cA = (const char*)Aglob + (size_t)cmt * tstep + (size_t)ck0 * 2;
  const char* cB = (const char*)Wt + (size_t)cnt_ * tstep + (size_t)ck0 * 2;
  bool c32 = (!which) && (cnt_ < 4);
  unsigned vb0[2], vb1[2];
#pragma unroll
  for (int i = 0; i < 2; ++i) { vb0[i] = voffB(i, 0, c32); vb1[i] = voffB(i, 1, c32); }
  G_STAGE(G_SB(0, 0), cB, vb0); G_STAGE(G_SA(0, 0), cA, voffA); G_STAGE(G_SB(0, 1), cB, vb1); G_STAGE(G_SA(0, 1), cA + hstep, voffA);
  if (wr == 1) G_BAR;
  G_WAIT_V(4); G_BAR;
  G_STAGE(G_SB(1, 0), cB + kstep, vb0); G_STAGE(G_SA(1, 0), cA + kstep, voffA); G_STAGE(G_SB(1, 1), cB + kstep, vb1);
  G_WAIT_V(6); G_BAR;
  for (;;) {
    const int ntn = next_unit(ct, nmt, nnt, nk0, nnk);
    const bool has_next = ntn >= 0;
    const char* nA = has_next ? (const char*)Aglob + (size_t)nmt * tstep + (size_t)nk0 * 2 : cA;
    const char* nB = has_next ? (const char*)Wt + (size_t)nnt * tstep + (size_t)nk0 * 2 : cB;
    const bool n32 = has_next ? ((!which) && (nnt < 4)) : c32;
    for (int t = 0; t < cnk; t += 2) {
      const bool last = (t == cnk - 2);
      const char* a1 = cA + (size_t)(t + 1) * kstep;
      const char* a2 = last ? nA : cA + (size_t)(t + 2) * kstep; const char* b2 = last ? nB : cB + (size_t)(t + 2) * kstep;
      const char* a3 = a2 + kstep; const char* b3 = b2 + kstep;
      if (last) {
#pragma unroll
        for (int i = 0; i < 2; ++i) { vb0[i] = voffB(i, 0, n32); vb1[i] = voffB(i, 1, n32); }
      }
      G_LDB(B0, 0, 0); G_SCHED; G_LDA(At, 0, 0); G_STAGE(G_SA(1, 1), a1 + hstep, voffA);
      G_WAIT_L(8); G_BAR; G_WAIT_L(0); G_MMA(0, 0, At, B0); G_BAR; G_SCHED;
      G_LDB(B1, 0, 1); G_STAGE(G_SB(0, 0), b2, vb0);
      G_BAR; G_WAIT_L(0); G_MMA(0, 1, At, B1); G_BAR;
      G_LDA(At, 0, 1); G_STAGE(G_SA(0, 0), a2, voffA);
      G_BAR; G_WAIT_L(0); G_MMA(1, 0, At, B0); G_BAR; G_SCHED;
      G_STAGE(G_SB(0, 1), b2, vb1);
      G_WAIT_V(6); G_BAR; G_MMA(1, 1, At, B1); G_BAR;
      G_LDB(B0, 1, 0); G_SCHED; G_LDA(At, 1, 0); G_STAGE(G_SA(0, 1), a2 + hstep, voffA);
      G_WAIT_L(8); G_BAR; G_WAIT_L(0); G_MMA(0, 0, At, B0); G_BAR; G_SCHED;
      G_LDB(B1, 1, 1); G_STAGE(G_SB(1, 0), b3, vb0);
      G_BAR; G_WAIT_L(0); G_MMA(0, 1, At, B1); G_BAR;
      G_LDA(At, 1, 1); G_STAGE(G_SA(1, 0), a3, voffA);
      G_BAR; G_WAIT_L(0); G_MMA(1, 0, At, B0); G_BAR; G_SCHED;
      G_STAGE(G_SB(1, 1), b3, vb1);
      G_WAIT_V(6); G_BAR; G_MMA(1, 1, At, B1); G_BAR;
    }
    if (GP == 0) {
      const int m0 = cmt * 256, n0 = cnt_ * 256;
      const bool isctx = (cmt % 9) == 0;
      const int head = wc >> 1;
      const int n128 = cnt_ * 2 + head;
      const int rowl0 = wr * 64 + fr;
      if (which) {
        const int colb = n0 + head * 128 + (wc & 1) * 32 + fq * 8;
        u16* ybase = isctx ? p.ypart + ((size_t)(ck0 >> 8) * 1024 + (size_t)(cmt / 9) * 256) * DM : p.y + (size_t)m0 * DM;
#pragma unroll
        for (int ai = 0; ai < 2; ++ai)
#pragma unroll
          for (int m = 0; m < 4; ++m) {
            u16* yp = ybase + (size_t)(rowl0 + ai * 128 + m * 16) * DM + colb;
#pragma unroll
            for (int bj = 0; bj < 2; ++bj) {
              u32x4 o;
              o[0] = pack2(acc[ai][bj][m][0][0], acc[ai][bj][m][0][1]); o[1] = pack2(acc[ai][bj][m][0][2], acc[ai][bj][m][0][3]);
              o[2] = pack2(acc[ai][bj][m][1][0], acc[ai][bj][m][1][1]); o[3] = pack2(acc[ai][bj][m][1][2], acc[ai][bj][m][1][3]);
              *(u32x4*)(yp + bj * 64) = o;
            }
          }
        __builtin_amdgcn_s_waitcnt(0x0F70);
      } else {
        int hh = 64; bool rope = false, silu = false; float qmul = 1.f; const float* ng = nullptr;
        if (n128 < 4) { hh = 32; rope = true; qmul = 0.125f * LOG2E; }
        else if (n128 < 8) { hh = 32; rope = true; }
        else if (n128 < 12) { }
        else if (n128 < 16) { rope = true; qmul = 0.08838834764831845f * LOG2E; }
        else if (n128 < 18) { rope = true; }
        else if (n128 < 20) { }
        else if (n128 < 24) { qmul = 0.08838834764831845f * LOG2E; }
        else if (n128 < 32) { }
        else if (n128 < 36) { rope = true; qmul = 0.08838834764831845f * LOG2E; ng = p.gq + l * 128; }
        else if (n128 < 38) { rope = true; ng = p.gk + l * 128; }
        else if (n128 < 40) { }
        else { silu = true; }
        const bool normtile = (cnt_ >= 16 && cnt_ < 19);
        const int c1 = (hh == 64) ? ((wc & 1) * 32 + fq * 8) : ((wc & 1) * 64 + fq * 8);
        const int c2 = c1 + hh;
        const int nfq = (hh == 64) ? 32 : 16;
        const int j0 = c1 & 63;
        const bool use_col = (j0 >= nfq);
        float frev[8];
#pragma unroll
        for (int e = 0; e < 8; ++e) frev[e] = rope ? fexp2(-(float)((j0 + e) & (nfq - 1)) * (13.287712379549449f / (float)nfq)) * 0.15915494309189535f : 0.f;
        float g1[8], g2[8];
#pragma unroll
        for (int e = 0; e < 8; ++e) { g1[e] = ng ? ng[c1 + e] : 1.f; g2[e] = ng ? ng[c2 + e] : 1.f; }
        if (normtile) {
#pragma unroll
          for (int ai = 0; ai < 2; ++ai)
#pragma unroll
            for (int m = 0; m < 4; ++m) {
              float ss = 0.f;
#pragma unroll
              for (int bj = 0; bj < 2; ++bj)
#pragma unroll
                for (int n = 0; n < 2; ++n)
#pragma unroll
                  for (int j = 0; j < 4; ++j) ss += acc[ai][bj][m][n][j] * acc[ai][bj][m][n][j];
              ss += swz_xor<16>(ss); ss = half_sum(ss);
              if (fq == 0) xs[(rowl0 + ai * 128 + m * 16) * 4 + wc] = ss;
            }
          G_WAIT_L(0); G_BAR;
        }
        float rinv8[8];
#pragma unroll
        for (int q = 0; q < 8; ++q) {
          const int rl = rowl0 + (q >> 2) * 128 + (q & 3) * 16;
          rinv8[q] = normtile ? rsqrtf((xs[rl * 4 + wc] + xs[rl * 4 + (wc ^ 1)]) * (1.f / 128.f) + EPSV) : 1.f;
        }
#pragma unroll
        for (int e = 0; e < 8; ++e) { asm volatile("" : "+v"(g1[e])); asm volatile("" : "+v"(g2[e])); }
#pragma unroll
        for (int ai = 0; ai < 2; ++ai)
#pragma unroll
          for (int m = 0; m < 4; ++m) {
            const int rl = rowl0 + ai * 128 + m * 16;
            const int R = m0 + rl;
            float x1[8], x2[8];
#pragma unroll
            for (int n = 0; n < 2; ++n)
#pragma unroll
              for (int j = 0; j < 4; ++j) { x1[n * 4 + j] = acc[ai][0][m][n][j]; x2[n * 4 + j] = acc[ai][1][m][n][j]; }
            if (ng) {
              const float rinv = rinv8[ai * 4 + m];
#pragma unroll
              for (int e = 0; e < 8; ++e) { x1[e] = (x1[e] * rinv) * g1[e]; x2[e] = (x2[e] * rinv) * g2[e]; }
            }
            if (rope && !isctx) {
              const int tt = (R % TPB) - 256;
              const float pos = (float)(use_col ? (tt & 63) : (tt >> 6));
#pragma unroll
              for (int e = 0; e < 8; ++e) {
                float rev = pos * frev[e];
                rev = rev - floorf(rev);
                const float cs = __builtin_amdgcn_cosf(rev), sn = __builtin_amdgcn_sinf(rev);
                const float a = x1[e], bq = x2[e];
                x1[e] = a * cs - bq * sn; x2[e] = bq * cs + a * sn;
              }
            }
            if (silu) {
#pragma unroll
              for (int e = 0; e < 8; ++e) { x1[e] = x1[e] * __builtin_amdgcn_rcpf(1.f + fexp2(-LOG2E * x1[e])); x2[e] = x2[e] * __builtin_amdgcn_rcpf(1.f + fexp2(-LOG2E * x2[e])); }
            } else {
#pragma unroll
              for (int e = 0; e < 8; ++e) { x1[e] *= qmul; x2[e] *= qmul; }
            }
            u16* pp = p.P + (size_t)R * INW + n0 + head * 128;
            u32x4 o;
            o[0] = pack2(x1[0], x1[1]); o[1] = pack2(x1[2], x1[3]); o[2] = pack2(x1[4], x1[5]); o[3] = pack2(x1[6], x1[7]);
            *(u32x4*)(pp + c1) = o;
            o[0] = pack2(x2[0], x2[1]); o[1] = pack2(x2[2], x2[3]); o[2] = pack2(x2[4], x2[5]); o[3] = pack2(x2[6], x2[7]);
            *(u32x4*)(pp + c2) = o;
          }
      }
    }
    if (!has_next) break;
#pragma unroll
    for (int a = 0; a < 2; ++a)
#pragma unroll
      for (int b = 0; b < 2; ++b)
#pragma unroll
        for (int m = 0; m < 4; ++m)
#pragma unroll
          for (int n = 0; n < 2; ++n) acc[a][b][m][n] = (f32x4){0.f, 0.f, 0.f, 0.f};
    ct = ntn; cmt = nmt; cnt_ = nnt; ck0 = nk0; cnk = nnk; cA = nA; cB = nB; c32 = n32;
  }
  G_WAIT_V(0);
  if (wr == 0) G_BAR;
  G_BAR;
#undef G_SA
#undef G_SB
#undef G_STAGE
#undef G_LDA
#undef G_LDB
#undef G_MMA
#undef G_WAIT_V
#undef G_WAIT_L
#undef G_BAR
#undef G_SCHED
}

template <int PM> DI void attn_phase(const Params& p, int l, char* smem, int* s_item, int wv, int cidx) {
  int lane_; asm volatile("v_mbcnt_lo_u32_b32 %0, -1, 0\n\tv_mbcnt_hi_u32_b32 %0, -1, %0" : "=v"(lane_)); asm volatile("" : "+s"(wv));
  const int tid_ = wv * 64 + lane_;
  const int tid = tid_, lane = lane_, w = wv, h = lane >> 5, l31 = lane & 31;
  const int n_items = 512 + (l < 3 ? 64 : 0);
  char* Kb0 = smem;
  char* Vb0 = smem + 34816;
  float* rpb_s = (float*)(smem + 75776);
  float* sg_s = (float*)(smem + 77696);
  char* gate_s = smem + 78336;
  if (tid < 128) sg_s[tid] = p.subln_g[l * 128 + tid];
  const float li_ = (l == 0) ? 0.2f : (l == 1) ? 0.35550906759096926f : (l == 2) ? 0.47071301834358416f : 0.5560582041556405f;
  const float lambda_init = __uint_as_float(__builtin_amdgcn_readfirstlane(__float_as_uint(li_)));
  float lam;
  {
    float d1 = p.lq1[l * 64 + lane] * p.lk1[l * 64 + lane];
    float d2 = p.lq2[l * 64 + lane] * p.lk2[l * 64 + lane];
    d1 = wave_sum(d1); d2 = wave_sum(d2);
    lam = expf(d1) - expf(d2) + lambda_init;
    lam = __uint_as_float(__builtin_amdgcn_readfirstlane(__float_as_uint(lam)));
  }
  const int trow = tid >> 4, tch = tid & 15;
  if (tid == 0) *s_item = atomicAdd(p.counters + cidx, 1);
  for (;;) {
    __syncthreads();
    const int item = *s_item;
    if (item >= n_items) break;
    int nxt_item = 0;
    int mixer, b, head, qt; bool isctx;
    if (item < 512) {
      const int mo = item >> 7; mixer = (mo == 0) ? 0 : (mo == 1) ? 3 : (mo == 2) ? 2 : 1;
      const int rem = item & 127; b = rem >> 5; head = (rem >> 3) & 3; qt = rem & 7; isctx = false;
    } else {
      const int ci = item - 512; mixer = ci >> 4;
      const int rem = ci & 15; b = rem >> 2; head = rem & 3; qt = 0; isctx = true;
    }
    int qoff, koff, voff;
    if (mixer == 0) { qoff = head * 128; koff = 512 + head * 128; voff = 1024 + head * 128; }
    else if (mixer == 1) { qoff = 1536 + head * 128; koff = 2048 + (head >> 1) * 128; voff = 2304 + (head >> 1) * 128; }
    else if (mixer == 2) { qoff = 2560 + head * 128; koff = 3072 + head * 128; voff = 3584 + head * 128; }
    else { qoff = 4096 + head * 128; koff = 4608 + (head >> 1) * 128; voff = 4864 + (head >> 1) * 128; }
    const int Rb = b * TPB;
    const int Rq = Rb + (isctx ? 0 : 256) + qt * 256 + w * 32 + l31;
    int nplain, nlocal = 0, local_t0 = 0, mode = 0;
    if (isctx) nplain = 4;
    else if (mixer == 0 || mixer == 3) nplain = 36;
    else if (mixer == 1) {
      nplain = 4; mode = 1;
      const int ts = max(0, qt * 256 - 128), te = min(2048, qt * 256 + 384);
      local_t0 = ts; nlocal = (te - ts) >> 6;
    } else {
      nplain = 4; mode = 2;
      const int r0 = 4 * qt;
      const int lo = min(max(r0 - 4, 0), 24), hi = min(max(r0 - 1, 0), 24) + 8;
      local_t0 = lo * 64; nlocal = hi - lo;
    }
    const int ntl = nplain + nlocal;
    const int tq0 = qt * 256 + w * 32;
    const int tq = tq0 + l31;
    const int qrow = tq0 >> 6, qcol = tq & 63;
    const int kr0 = min(max(qrow - 4, 0), 24);
    const int cstart = min(max(qcol - 8, 0), 48);
    if (mode == 2) {
      if (tid < 465) rpb_s[tid] = p.rpb[(l * 4 + head) * 465 + tid] * LOG2E;
    }
    {
      const u16* gsrc = p.P + (size_t)(Rb + (isctx ? 0 : 256) + qt * 256 + (tid >> 4)) * INW + 5120 + mixer * 512 + head * 128 + (tid & 15) * 8;
      u32x4 gt[8];
#pragma unroll
      for (int j = 0; j < 8; ++j) gt[j] = *(const u32x4*)(gsrc + (size_t)j * 32 * INW);
#pragma unroll
      for (int j = 0; j < 8; ++j) *(u32x4*)(gate_s + ((tid >> 4) + 32 * j) * 264 + (tid & 15) * 16) = gt[j];
    }
    const int npass = (mixer == 0) ? 2 : 1;
    const bool full_d = (mixer != 0);
    float* asave = p.asave + (size_t)Rq * 512 + head * 128 + 4 * h;

    for (int pass = 0; pass < npass; ++pass) {
      bf16x8 qf[8];
      {
        const u16* qp = p.P + (size_t)Rq * INW + qoff + pass * 64 + h * 8;
#pragma unroll
        for (int ks = 0; ks < 4; ++ks) qf[ks] = *(const bf16x8*)(qp + ks * 16);
#pragma unroll
        for (int ks = 4; ks < 8; ++ks) qf[ks] = full_d ? *(const bf16x8*)(qp + ks * 16) : (bf16x8){0, 0, 0, 0, 0, 0, 0, 0};
      }
      const int dofs_b = pass * 128;
      f32x16 Oacc[4];
#pragma unroll
      for (int db = 0; db < 4; ++db)
#pragma unroll
        for (int e = 0; e < 16; ++e) Oacc[db][e] = 0.f;
      float m = -1e30f, lsum = 0.f;
      u32x4 kst[2], vst[2];
      __syncthreads();
      {
        const u16* base = p.P + (size_t)(Rb + trow) * INW + tch * 8;
#pragma unroll
        for (int j = 0; j < 2; ++j) {
          kst[j] = *(const u32x4*)(base + (size_t)j * 32 * INW + koff);
          vst[j] = *(const u32x4*)(base + (size_t)j * 32 * INW + voff);
        }
#pragma unroll
        for (int j = 0; j < 2; ++j) {
          *(u32x4*)(Kb0 + (trow + 32 * j) * 272 + tch * 16) = kst[j];
          *(u32x4*)(Vb0 + (trow + 32 * j) * 320 + tch * 16) = vst[j];
        }
        const int R1 = (1 < nplain) ? Rb + 64 : Rb + 256 + local_t0 + 64 * (1 - nplain);
        const u16* b1 = p.P + (size_t)(R1 + trow) * INW + tch * 8;
        if (ntl > 1) {
#pragma unroll
          for (int j = 0; j < 2; ++j) {
            kst[j] = *(const u32x4*)(b1 + (size_t)j * 32 * INW + koff);
            vst[j] = *(const u32x4*)(b1 + (size_t)j * 32 * INW + voff);
          }
        }
      }
      __syncthreads();
      const bool shift = ATT_SKEW && (w >= 4);
      bool pend = false;
      int vcur = 0;
      bf16x8 pf[2][2];
#pragma unroll
      for (int kb = 0; kb < 2; ++kb)
#pragma unroll
        for (int s2 = 0; s2 < 2; ++s2) pf[kb][s2] = (bf16x8){0, 0, 0, 0, 0, 0, 0, 0};
      const int vlane = (4 * h + ((lane & 15) >> 2)) * 320 + (16 * ((lane >> 4) & 1) + 4 * (lane & 3)) * 2;
#define ATT_VLO(VC, t) tr_read((VC) + ((((t) >> 1) & 1) * 32 + 16 * ((t) & 1)) * 320 + ((t) >> 2) * 64)
#define ATT_VHI(VC, t) tr_read((VC) + ((((t) >> 1) & 1) * 32 + 16 * ((t) & 1) + 8) * 320 + ((t) >> 2) * 64)
#define ATT_PV_PRE(VBUF) do { const char* Vc = Vb0 + (VBUF) * 20480 + vlane; \
        _Pragma("unroll") for (int t = 0; t < 1; ++t) { vlo[t] = ATT_VLO(Vc, t); vhi[t] = ATT_VHI(Vc, t); } } while (0)
#define ATT_PV_RUN(VBUF) do { const char* Vc = Vb0 + (VBUF) * 20480 + vlane; \
        _Pragma("unroll") for (int t = 1; t < 4; ++t) { vlo[t] = ATT_VLO(Vc, t); vhi[t] = ATT_VHI(Vc, t); } \
        _Pragma("unroll") for (int t = 0; t < 16; ++t) { \
          const bf16x8 vf = __builtin_shufflevector(vlo[t & 3], vhi[t & 3], 0, 1, 2, 3, 4, 5, 6, 7); \
          Oacc[t >> 2] = mfma32(vf, pf[(t >> 1) & 1][t & 1], Oacc[t >> 2]); \
          if (t + 4 < 16) { vlo[t & 3] = ATT_VLO(Vc, t + 4); vhi[t & 3] = ATT_VHI(Vc, t + 4); } \
          __builtin_amdgcn_sched_barrier(0); } } while (0)
#define ATT_PV(VBUF) do { s16x4 vlo[4], vhi[4]; ATT_PV_PRE(VBUF); ATT_PV_RUN(VBUF); } while (0)
      for (int i = 0; i < ntl; ++i) {
        const int cur = i & 1;
        const int vprev = vcur ^ 1, vnext = vcur ^ 1;
        const bool more = (i + 1 < ntl);
        if (PM != 2 && more) {
#pragma unroll
          for (int j = 0; j < 2; ++j) {
            *(u32x4*)(Kb0 + (cur ^ 1) * 17408 + (trow + 32 * j) * 272 + tch * 16) = kst[j];
            *(u32x4*)(Vb0 + vnext * 20480 + (trow + 32 * j) * 320 + tch * 16) = vst[j];
          }
        }
        if (PM != 2 && i + 2 < ntl) {
          const int inx = i + 2;
          const int Rn = (inx < nplain) ? Rb + 64 * inx : Rb + 256 + local_t0 + 64 * (inx - nplain);
          const u16* nbase = p.P + (size_t)(Rn + trow) * INW + tch * 8;
#pragma unroll
          for (int j = 0; j < 2; ++j) {
            kst[j] = *(const u32x4*)(nbase + (size_t)j * 32 * INW + koff);
            vst[j] = *(const u32x4*)(nbase + (size_t)j * 32 * INW + voff);
          }
        }
        __builtin_amdgcn_sched_barrier(0);
        if (shift && pend) { ATT_PV(vprev); pend = false; }
        bool active = (PM != 1);
        const int tpos = local_t0 + 64 * (i - nplain);
        if (i >= nplain) {
          if (mode == 1) active = (PM != 1) && (tpos + 63 >= tq0 - 128) && (tpos <= tq0 + 31 + 128);
          else { const int dr = (tpos >> 6) - kr0; active = (PM != 1) && (dr >= 0 && dr < 8); }
        }
        f32x16 sacc[2];
        if (active) {
#pragma unroll
          for (int kb = 0; kb < 2; ++kb)
#pragma unroll
            for (int e = 0; e < 16; ++e) sacc[kb][e] = 0.f;
          const char* Kc = Kb0 + cur * 17408 + l31 * 272 + dofs_b + h * 16;
          bf16x8 kf[8];
          if (full_d) {
#pragma unroll
            for (int j = 0; j < 8; ++j) kf[j] = *(const bf16x8*)(Kc + (j >> 3) * 32 * 272 + (j & 7) * 32);
#pragma unroll
            for (int j = 0; j < 16; ++j) {
              sacc[j >> 3] = mfma32(kf[j & 7], qf[j & 7], sacc[j >> 3]);
              if (j + 8 < 16) kf[j & 7] = *(const bf16x8*)(Kc + ((j + 8) >> 3) * 32 * 272 + ((j + 8) & 7) * 32);
              __builtin_amdgcn_sched_barrier(0);
            }
          } else {
#pragma unroll
            for (int j = 0; j < 4; ++j) kf[j] = *(const bf16x8*)(Kc + (j >> 2) * 32 * 272 + (j & 3) * 32);
#pragma unroll
            for (int j = 0; j < 8; ++j) {
              sacc[j >> 2] = mfma32(kf[j & 3], qf[j & 3], sacc[j >> 2]);
              if (j + 4 < 8) kf[j & 3] = *(const bf16x8*)(Kc + ((j + 4) >> 2) * 32 * 272 + ((j + 4) & 3) * 32);
              __builtin_amdgcn_sched_barrier(0);
            }
          }
        }
        s16x4 vlo[4], vhi[4];
        if (active && !shift) ATT_PV_PRE(vcur);
        if (active) {
          if (i >= nplain) {
            if (mode == 1) {
              const int dbase = tpos - tq + 4 * h;
#pragma unroll
              for (int kb = 0; kb < 2; ++kb)
#pragma unroll
                for (int e = 0; e < 16; ++e) {
                  const int d = dbase + kb * 32 + (e & 3) + 8 * (e >> 2);
                  sacc[kb][e] = (d <= 128 && d >= -128) ? sacc[kb][e] : -1e30f;
                }
            } else {
              const int kr = tpos >> 6;
              const int rbase = (kr - qrow + 7) * 31 + (15 - qcol);
#pragma unroll
              for (int kb = 0; kb < 2; ++kb)
#pragma unroll
                for (int e = 0; e < 16; ++e) {
                  const int kidx = kb * 32 + (e & 3) + 8 * (e >> 2) + 4 * h;
                  const int dc = kidx - cstart;
                  const bool valid = dc >= 0 && dc < 16;
                  const float bias = rpb_s[valid ? rbase + kidx : 0];
                  sacc[kb][e] = valid ? sacc[kb][e] + bias : -1e30f;
                }
            }
          }
          float mt = sacc[0][0];
#pragma unroll
          for (int e = 1; e < 16; ++e) mt = fmaxf(mt, sacc[0][e]);
#pragma unroll
          for (int e = 0; e < 16; ++e) mt = fmaxf(mt, sacc[1][e]);
          mt = half_max(mt);
          if (__builtin_amdgcn_ballot_w64(mt > m + 8.f) != 0ull) {
            const float mnew = fmaxf(m, mt);
            const float alpha = fexp2(m - mnew);
            m = mnew;
            lsum *= alpha;
#pragma unroll
            for (int db = 0; db < 4; ++db)
#pragma unroll
              for (int e = 0; e < 16; ++e) Oacc[db][e] *= alpha;
          }
          float ps = 0.f;
#pragma unroll
          for (int kb = 0; kb < 2; ++kb)
#pragma unroll
            for (int e = 0; e < 16; ++e) { const float pv = fexp2(sacc[kb][e] - m); sacc[kb][e] = pv; ps += pv; }
          lsum += ps;
#pragma unroll
          for (int kb = 0; kb < 2; ++kb)
#pragma unroll
            for (int s2 = 0; s2 < 2; ++s2) {
              u32x4 t;
              t[0] = pack2(sacc[kb][8 * s2 + 0], sacc[kb][8 * s2 + 1]);
              t[1] = pack2(sacc[kb][8 * s2 + 2], sacc[kb][8 * s2 + 3]);
              t[2] = pack2(sacc[kb][8 * s2 + 4], sacc[kb][8 * s2 + 5]);
              t[3] = pack2(sacc[kb][8 * s2 + 6], sacc[kb][8 * s2 + 7]);
              pf[kb][s2] = __builtin_bit_cast(bf16x8, t);
            }
          if (!shift) ATT_PV_RUN(vcur); else pend = true;
        }
        vcur = vnext;
        __syncthreads();
      }
      if (shift && pend) { const int vlast = vcur ^ 1; ATT_PV(vlast); }
#undef ATT_PV
#undef ATT_PV_PRE
#undef ATT_PV_RUN
#undef ATT_VLO
#undef ATT_VHI
      if (pass == npass - 1 && tid == 0) nxt_item = atomicAdd(p.counters + cidx, 1);
      float lt = half_sum(lsum);
      if (mixer == 1) lt += fexp2(p.sink[l * 4 + head] * LOG2E - m);
      const float inv = 1.f / lt;
      float ov[4][16];
#pragma unroll
      for (int db = 0; db < 4; ++db)
#pragma unroll
        for (int e = 0; e < 16; ++e) ov[db][e] = Oacc[db][e] * inv;
      if (mixer == 0 && pass == 0) {
#pragma unroll
        for (int db = 0; db < 4; ++db)
#pragma unroll
          for (int g = 0; g < 4; ++g) {
            f32x4 o;
#pragma unroll
            for (int e = 0; e < 4; ++e) o[e] = ov[db][4 * g + e];
            *(f32x4*)(asave + db * 32 + 8 * g) = o;
          }
        continue;
      }
      float rr = 1.f;
      if (mixer == 0) {
        float ss = 0.f;
        const float* ap = asave;
#pragma unroll
        for (int db = 0; db < 4; ++db) {
          asm volatile("" : "+v"(ap), "+v"(ss));
#pragma unroll
          for (int g = 0; g < 4; ++g) {
            const f32x4 sv = *(const f32x4*)(ap + db * 32 + 8 * g);
#pragma unroll
            for (int e = 0; e < 4; ++e) { const float o = sv[e] - lam * ov[db][4 * g + e]; ov[db][4 * g + e] = o; ss += o * o; }
          }
        }
        ss = half_sum(ss);
        rr = rsqrtf(ss * (1.f / 128.f) + EPSV) * (1.f - lambda_init);
      }
      {
        const char* gl = gate_s + (w * 32 + l31) * 264 + 8 * h;
        u16* op = p.O + (size_t)Rq * DM + mixer * 512 + head * 128 + 4 * h;
        const float* sg = sg_s + 4 * h;
#pragma unroll
        for (int db = 0; db < 4; ++db)
#pragma unroll
          for (int g = 0; g < 4; ++g) {
            const int d = db * 32 + 8 * g;
            f32x4 sv = {1.f, 1.f, 1.f, 1.f};
            if (mixer == 0) sv = *(const f32x4*)(sg + d);
            const u32x2 gv = *(const u32x2*)(gl + d * 2);
            u32x2 o;
            o[0] = pack2(ov[db][4 * g + 0] * rr * sv[0] * bf_lo(gv[0]), ov[db][4 * g + 1] * rr * sv[1] * bf_hi(gv[0]));
            o[1] = pack2(ov[db][4 * g + 2] * rr * sv[2] * bf_lo(gv[1]), ov[db][4 * g + 3] * rr * sv[3] * bf_hi(gv[1]));
            *(u32x2*)(op + d) = o;
          }
      }
    }
    if (tid == 0) *s_item = nxt_item;
  }
}

#define XB_TMO      128
#define XB_XCNT(j)  (256  + 64 * (j))
#define XB_XSUB(j)  (1280 + 64 * (j))
#define XB_XGEN(j)  (2304 + 64 * (j))
#define XB_TOP      3328
#define XB_TOPGEN   3392
#define XCD_BAR_WORDS 3456
#define XB_SPIN_CAP (1u << 20)
DI unsigned xb_ld(unsigned* p)              { return __hip_atomic_load(p, __ATOMIC_RELAXED, __HIP_MEMORY_SCOPE_AGENT); }
DI unsigned xb_add(unsigned* p, unsigned v) { return __hip_atomic_fetch_add(p, v, __ATOMIC_RELAXED, __HIP_MEMORY_SCOPE_AGENT); }
DI unsigned xb_xcc_id() { return (unsigned)__builtin_amdgcn_s_getreg((3 << 11) | 20) & 0xFu; }
#define XB_SPIN(cond, bar) do { unsigned _sp = 0; while (cond) { __builtin_amdgcn_s_sleep(1); \
    if ((++_sp & 255u) == 0u) { if (xb_ld(&(bar)[XB_TMO])) break; if (_sp > XB_SPIN_CAP) { atomicAdd(&(bar)[XB_TMO], 1u); break; } } } } while (0)
DI void xcd_barrier_complete(unsigned* bar, unsigned x, unsigned& nloc, unsigned& nx) {
  const unsigned G = gridDim.x;
  unsigned sum, cnt, mine, sp = 0u;
  for (;;) {
    sum = 0u; cnt = 0u; mine = 0u;
#pragma unroll
    for (unsigned j = 0; j < 16; ++j) { const unsigned c = xb_ld(&bar[XB_XCNT(j)]); sum += c; cnt += (c > 0u) ? 1u : 0u; mine = (j == x) ? c : mine; }
    if (sum == G) break;
    __builtin_amdgcn_s_sleep(1);
    if ((++sp & 255u) == 0u) { if (xb_ld(&bar[XB_TMO])) break; if (sp > XB_SPIN_CAP) { atomicAdd(&bar[XB_TMO], 1u); break; } }
  }
  nloc = mine > 0u ? mine : 1u; nx = cnt > 0u ? cnt : 1u;
}
DI bool xb_leader_lane(int wv) {
  int lane_; asm volatile("v_mbcnt_lo_u32_b32 %0, -1, 0\n\tv_mbcnt_hi_u32_b32 %0, -1, %0" : "=v"(lane_));
  return wv == 0 && lane_ == 0;
}
DI void xcd_barrier(unsigned* bar, volatile LAS unsigned* st, int wv) {
  asm volatile("s_waitcnt vmcnt(0)" ::: "memory");
  __syncthreads();
  if (xb_leader_lane(wv)) {
    __builtin_amdgcn_s_waitcnt(0);
    const unsigned x = xb_xcc_id();
    unsigned nloc = st[0], nx = st[1];
    if (nloc == 0u) { xcd_barrier_complete(bar, x, nloc, nx); st[0] = nloc; st[1] = nx; }
    const unsigned old = xb_add(&bar[XB_XSUB(x)], 1u);
    const unsigned gen = old / nloc;
    if (old + 1u == (gen + 1u) * nloc) {
      __builtin_amdgcn_fence(__ATOMIC_RELEASE, "agent");
      asm volatile("s_waitcnt vmcnt(0)" ::: "memory");
      const unsigned og = xb_add(&bar[XB_TOP], 1u);
      const unsigned tg = og / nx;
      if (og + 1u == (tg + 1u) * nx) xb_add(&bar[XB_TOPGEN], 1u);
      else XB_SPIN(xb_ld(&bar[XB_TOPGEN]) == tg, bar);
      __builtin_amdgcn_fence(__ATOMIC_ACQUIRE, "agent");
      xb_add(&bar[XB_XGEN(x)], 1u);
      asm volatile("s_waitcnt vmcnt(0)" ::: "memory");
    } else {
      XB_SPIN(xb_ld(&bar[XB_XGEN(x)]) == gen, bar);
      __builtin_amdgcn_fence(__ATOMIC_ACQUIRE, "agent");
      asm volatile("s_waitcnt vmcnt(0)" ::: "memory");
    }
  }
  __syncthreads();
}

__global__ void __launch_bounds__(512, 1) mega_kernel(Params p) {
  __shared__ __attribute__((aligned(16))) char smem[SMEM_BYTES + 16];
  int* s_item_p = (int*)(smem + SMEM_BYTES);
  volatile LAS unsigned* xb_st = (volatile LAS unsigned*)(smem + SMEM_BYTES + 8);
  cg::grid_group grid = cg::this_grid();
  const int wv = __builtin_amdgcn_readfirstlane(threadIdx.x >> 6);
  if (xb_leader_lane(wv)) { xb_st[0] = 0u; xb_st[1] = 0u; (void)xb_add(&p.bar[XB_XCNT(xb_xcc_id())], 1u); }
  __syncthreads();
  for (int ph = p.phase_lo; ph <= p.phase_hi; ++ph) {
    if (ph == p.phase_lo + 1) grid.sync();
    else if (ph > p.phase_lo + 1) xcd_barrier(p.bar, xb_st, wv);
#pragma unroll 1
    for (int rep = 0; rep < 2; ++rep) {
      if (rep == 1) {
        const bool dup = (DUP_SUB == -2) ? (ph == 0) : (ph >= 3 && ((ph - 3) & 3) == DUP_SUB);
        if (!dup) break;
        grid.sync();
      }
      if (ph == 0) phase0(p, smem, wv);
      else if (ph == 1) phase1(p, wv);
      else if (ph == 2) rowpass(p, 0, true, wv, smem);
      else {
        const int l = (ph - 3) >> 2, sub = (ph - 3) & 3;
        if (sub == 0) { if (DUP_SUB == 0 && rep == 0) gemm_phase<GEMM_PROBE>(p, l, 0, smem, wv); else gemm_phase<0>(p, l, 0, smem, wv); }
        else if (sub == 2) gemm_phase<0>(p, l, 1, smem, wv);
        else if (sub == 1) { if (DUP_SUB == 1 && rep == 0) attn_phase<ATT_PROBE>(p, l, smem, s_item_p, wv, l + 4); else attn_phase<0>(p, l, smem, s_item_p, wv, l); }
        else rowpass(p, l, false, wv, smem);
      }
    }
  }
}

extern "C" void kernel_launch(void* const* d_in, const int* in_sizes, int n_in, void* d_out, int out_size,
                              void* d_ws, size_t ws_size, hipStream_t stream) {
  Params p{};
  p.x = (const float*)d_in[0]; p.c = (const float*)d_in[1]; p.ctx = (const float*)d_in[2]; p.c_ctx = (const float*)d_in[3];
  p.w_mod = (const float*)d_in[4]; p.b_mod = (const float*)d_in[5]; p.pre_g = (const float*)d_in[6]; p.w_in = (const float*)d_in[7];
  p.lq1 = (const float*)d_in[8]; p.lk1 = (const float*)d_in[9]; p.lq2 = (const float*)d_in[10]; p.lk2 = (const float*)d_in[11];
  p.subln_g = (const float*)d_in[12]; p.sink = (const float*)d_in[13]; p.rpb = (const float*)d_in[14];
  p.gq = (const float*)d_in[15]; p.gk = (const float*)d_in[16]; p.w_out = (const float*)d_in[17]; p.post_g = (const float*)d_in[18];
  p.out = (float*)d_out;
  char* ws = (char*)d_ws;
  size_t off = 0;
  auto carve = [&](size_t bytes) { char* r = ws + off; off += (bytes + 255) & ~(size_t)255; return r; };
  p.wt_in = (u16*)carve((size_t)4 * INW * DM * 2);
  p.wt_out = (u16*)carve((size_t)4 * DM * DM * 2);
  p.nbuf = (u16*)carve((size_t)NTOK * DM * 2);
  p.P = (u16*)carve((size_t)NTOK * INW * 2);
  p.O = (u16*)carve((size_t)NTOK * DM * 2);
  p.y = (u16*)carve((size_t)NTOK * DM * 2);
  p.ypart = (u16*)carve((size_t)8 * 1024 * DM * 2);
  p.hc = (float*)carve((size_t)1024 * DM * 4);
  p.modpart = (float*)carve((size_t)16 * 4 * 30720 * 4);
  p.mod = (float*)carve((size_t)4 * 30720 * 4);
  p.rope128 = (float*)carve((size_t)2048 * 64 * 2 * 4);
  p.rope64 = (float*)carve((size_t)2048 * 32 * 2 * 4);
  p.asave = (float*)carve((size_t)NTOK * 512 * 4);
  p.counters = (int*)carve(256);
  p.bar = (unsigned*)carve((size_t)XCD_BAR_WORDS * 4);
  p.phase_lo = 0; p.phase_hi = 18;
  static int grid_blocks = 0;
  if (!grid_blocks) {
    int dev = 0, cus = 0, per_cu = 0;
    (void)hipGetDevice(&dev);
    (void)hipDeviceGetAttribute(&cus, hipDeviceAttributeMultiprocessorCount, dev);
    (void)hipOccupancyMaxActiveBlocksPerMultiprocessor(&per_cu, mega_kernel, NTHR, 0);
    if (per_cu > 1) per_cu = 1;
    if (per_cu < 1) per_cu = 1;
    grid_blocks = cus * per_cu;
  }
  (void)hipMemsetAsync(p.bar, 0, (size_t)XCD_BAR_WORDS * 4, stream);
  void* args[] = {&p};
  hipError_t e = hipLaunchCooperativeKernel((void*)mega_kernel, dim3(grid_blocks), dim3(NTHR), args, 0, stream);
  if (e != hipSuccess) fprintf(stderr, "cooperative launch failed: %s (grid %d)\n", hipGetErrorString(e), grid_blocks);
}
```
